# Optimizing an MI355X kernel written in HIP

```python
import jax, jax.numpy as jnp
from jax import lax
import numpy as np

D_MODEL = 1024
BATCH = 4
SEQ = 4096
DEPTH = 4
DEC_BATCH = 8
DEC_SEQ = 32
PAST_LEN = 4096

CHUNK = 64
NORM_EPS = 1e-6
GLA_HEADS = 4
GLA_DK = D_MODEL // 2
GLA_DV = D_MODEL
GLA_HK = GLA_DK // GLA_HEADS
GLA_HV = GLA_DV // GLA_HEADS
GLA_RANK = 16
GLA_TAU = 16.0
LRU_WIDTH = D_MODEL
LRU_BLOCKS = 8
LRU_BS = LRU_WIDTH // LRU_BLOCKS
CONV_WIDTH = 4
LRU_C = 8.0
RWKV_WIDTH = D_MODEL
RWKV_HD = 64
RWKV_HEADS = RWKV_WIDTH // RWKV_HD
DECAY_RANK = 64
AAA_RANK = 64
RWKV_GN_EPS = 64e-5
SHIFT_WIDTH = 3 * RWKV_WIDTH + DECAY_RANK + AAA_RANK
N_BRANCH = 3
SPLITS = (GLA_DK, GLA_DK, GLA_DV, GLA_RANK, GLA_DV, LRU_WIDTH, LRU_WIDTH, SHIFT_WIDTH, RWKV_WIDTH, N_BRANCH * D_MODEL)
SPLIT_IDX = tuple(int(s) for s in np.cumsum(SPLITS)[:-1])
D_IN = int(sum(SPLITS))
RWKV_SPLIT_IDX = (RWKV_WIDTH, 2 * RWKV_WIDTH, 3 * RWKV_WIDTH, 3 * RWKV_WIDTH + DECAY_RANK)

kernel_name = 'hybrid_gla_rglru_rwkv7_stream_step'


def rmsnorm(x, g):
    xf = x.astype(jnp.float32)
    y = xf * lax.rsqrt(jnp.mean(xf * xf, axis=-1, keepdims=True) + NORM_EPS)
    return (y * g.astype(jnp.float32)).astype(x.dtype)


def gla_branch(q, k, v, gd, w_gup, b_g, norm_g, s0):
    f32 = jnp.float32
    B, L, _ = q.shape
    log_a = jax.nn.log_sigmoid(gd.astype(f32) @ w_gup.astype(f32) + b_g.astype(f32)) / GLA_TAU
    c = CHUNK if L % CHUNK == 0 else L
    n = L // c

    def to_blocks(t, hd):
        return t.astype(f32).reshape(B, n, c, GLA_HEADS, hd).transpose(1, 0, 3, 2, 4)

    qb = to_blocks(q, GLA_HK) * (GLA_HK ** -0.5)
    kb = to_blocks(k, GLA_HK)
    vb = to_blocks(v, GLA_HV)
    ab = to_blocks(log_a, GLA_HK)
    causal = jnp.tril(jnp.ones((c, c), dtype=bool))[:, :, None]

    def step(S, blk):
        qc, kc, vc, ac = blk
        b = jnp.cumsum(ac, axis=2)
        diff = b[:, :, :, None, :] - b[:, :, None, :, :]
        decay = jnp.exp(jnp.where(causal, diff, -jnp.inf))
        scores = jnp.einsum('bhid,bhjd,bhijd->bhij', qc, kc, decay)
        o = (jnp.einsum('bhid,bhde->bhie', qc * jnp.exp(b), S)
             + jnp.einsum('bhij,bhje->bhie', scores, vc))
        b_end = b[:, :, -1:, :]
        S = (S * jnp.exp(b_end)[:, :, 0, :, None]
             + jnp.einsum('bhjd,bhje->bhde', kc * jnp.exp(b_end - b), vc))
        return S, o

    S, o = lax.scan(step, s0.astype(f32), (qb, kb, vb, ab))
    o = o.transpose(1, 0, 3, 2, 4).reshape(B, L, GLA_HEADS, GLA_HV)
    o = o * lax.rsqrt(jnp.mean(o * o, axis=-1, keepdims=True) + NORM_EPS)
    o = o * norm_g.astype(f32).reshape(GLA_HEADS, GLA_HV)
    return o.reshape(B, L, GLA_DV), S


def rglru_branch(xb, conv_w, conv_b, w_a, b_a, w_x, b_x, lam, conv0, h0):
    f32 = jnp.float32
    B, L, W = xb.shape
    xp = jnp.concatenate([conv0.astype(f32), xb.astype(f32)], axis=1)
    cw = conv_w.astype(f32)
    xc = sum(xp[:, t:t + L] * cw[t] for t in range(CONV_WIDTH)) + conv_b.astype(f32)
    new_conv = xp[:, L:]
    xblk = xc.reshape(B, L, LRU_BLOCKS, LRU_BS)
    r = jax.nn.sigmoid(jnp.einsum('blni,nij->blnj', xblk, w_a.astype(f32)).reshape(B, L, W) + b_a.astype(f32))
    i = jax.nn.sigmoid(jnp.einsum('blni,nij->blnj', xblk, w_x.astype(f32)).reshape(B, L, W) + b_x.astype(f32))
    log_a = -LRU_C * r * jax.nn.softplus(-lam.astype(f32))
    a = jnp.exp(log_a)
    u = jnp.sqrt(-jnp.expm1(2.0 * log_a)) * (i * xc)

    def comb(lft, rgt):
        a1, b1 = lft
        a2, b2 = rgt
        return a1 * a2, a2 * b1 + b2

    a_cum, h = lax.associative_scan(comb, (a, u), axis=1)
    h = h + a_cum * h0.astype(f32)[:, None, :]
    return h, new_conv, h[:, -1]


def rwkv7_branch(proj, shift0, mu, w0, w_up, a0, a_up, k_k, k_a, r_k, gn_w, gn_b, s0):
    f32 = jnp.float32
    B, L, _ = proj.shape
    pf = proj.astype(f32)
    prev = jnp.concatenate([shift0.astype(f32)[:, None, :], pf[:, :-1]], axis=1)
    xs = pf + (prev - pf) * mu.astype(f32)
    new_shift = proj[:, -1]
    r, k, v, wd, ad = jnp.split(xs, RWKV_SPLIT_IDX, axis=-1)
    w = w0.astype(f32) + jnp.tanh(wd) @ w_up.astype(f32)
    log_w = -jnp.exp(-jax.nn.softplus(-w) - 0.5)
    a = jax.nn.sigmoid(a0.astype(f32) + ad @ a_up.astype(f32))
    heads = lambda t: t.reshape(B, L, RWKV_HEADS, RWKV_HD)
    kk = heads(k * k_k.astype(f32))
    kk = kk * lax.rsqrt(jnp.sum(kk * kk, axis=-1, keepdims=True) + 1e-12)
    k = k * (1.0 + (a - 1.0) * k_a.astype(f32))
    rh, kh, vh, ah, wh = heads(r), heads(k), heads(v), heads(a), heads(jnp.exp(log_w))
    seq = (jnp.moveaxis(rh, 1, 0), jnp.moveaxis(wh, 1, 0), jnp.moveaxis(kh, 1, 0),
           jnp.moveaxis(vh, 1, 0), jnp.moveaxis(kk, 1, 0), jnp.moveaxis(ah, 1, 0))

    def step(S, inp):
        r_t, w_t, k_t, v_t, kk_t, a_t = inp
        sk = jnp.einsum('bhvk,bhk->bhv', S, kk_t)
        S = (S * w_t[:, :, None, :] - sk[..., None] * (kk_t * a_t)[:, :, None, :]
             + v_t[..., None] * k_t[:, :, None, :])
        return S, jnp.einsum('bhvk,bhk->bhv', S, r_t)

    S, y = lax.scan(step, s0.astype(f32), seq)
    y = jnp.moveaxis(y, 0, 1)
    mean = jnp.mean(y, axis=-1, keepdims=True)
    var = jnp.mean(jnp.square(y - mean), axis=-1, keepdims=True)
    y = ((y - mean) * lax.rsqrt(var + RWKV_GN_EPS) * gn_w.astype(f32).reshape(RWKV_HEADS, RWKV_HD)
         + gn_b.astype(f32).reshape(RWKV_HEADS, RWKV_HD))
    y = y + jnp.sum(rh * kh * r_k.astype(f32), axis=-1, keepdims=True) * vh
    return y.reshape(B, L, RWKV_WIDTH), new_shift, S


def run_trunk(x, gla0, lru_h0, lru_conv0, rwkv0, shift0, P):
    f32 = jnp.float32
    dt = x.dtype
    n_gla, n_h, n_conv, n_rw, n_shift = [], [], [], [], []
    for l in range(DEPTH):
        xn = rmsnorm(x, P['norm_g'][l])
        (q, k, v, gd, z_gla, xl, z_lru, rw, z_rw, gate_logits) = jnp.split(
            xn @ P['w_in'][l], SPLIT_IDX, axis=-1)
        o_gla, s_gla = gla_branch(q, k, v, gd, P['gla_w_gup'][l], P['gla_b_g'][l],
                                  P['gla_norm_g'][l], gla0[l])
        o_lru, conv_new, h_new = rglru_branch(xl, P['lru_conv_w'][l], P['lru_conv_b'][l],
                                              P['lru_w_a'][l], P['lru_b_a'][l], P['lru_w_x'][l],
                                              P['lru_b_x'][l], P['lru_lambda'][l],
                                              lru_conv0[l], lru_h0[l])
        o_rw, shift_new, s_rw = rwkv7_branch(rw, shift0[l], P['rwkv_mu'][l], P['rwkv_w0'][l],
                                             P['rwkv_w_up'][l], P['rwkv_a0'][l], P['rwkv_a_up'][l],
                                             P['rwkv_k_k'][l], P['rwkv_k_a'][l], P['rwkv_r_k'][l],
                                             P['rwkv_gn_w'][l], P['rwkv_gn_b'][l], rwkv0[l])
        g_a, g_b, g_c = jnp.split(jax.nn.sigmoid(gate_logits.astype(f32)), N_BRANCH, axis=-1)
        merged = (g_a * ((o_gla * jax.nn.silu(z_gla.astype(f32))) @ P['w_proj_gla'][l].astype(f32))
                  + g_b * ((o_lru * jax.nn.silu(z_lru.astype(f32))) @ P['w_proj_lru'][l].astype(f32))
                  + g_c * ((o_rw * jax.nn.silu(z_rw.astype(f32))) @ P['w_proj_rwkv'][l].astype(f32)))
        x = x + merged.astype(dt) @ P['w_out'][l]
        n_gla.append(s_gla.astype(dt))
        n_h.append(h_new.astype(dt))
        n_conv.append(conv_new.astype(dt))
        n_rw.append(s_rw.astype(dt))
        n_shift.append(shift_new.astype(dt))
    y = rmsnorm(x, P['final_norm_g'])
    return y, jnp.stack(n_gla), jnp.stack(n_h), jnp.stack(n_conv), jnp.stack(n_rw), jnp.stack(n_shift)


def setup_inputs(seed: int = 0) -> dict:
    key = jax.random.key(seed)
    ks = iter(jax.random.split(key, 48))
    f32 = jnp.float32

    def nrm(shape, s):
        return jax.random.normal(next(ks), shape, f32) * s

    def unif(shape, lo, hi):
        return jax.random.uniform(next(ks), shape, f32, lo, hi)

    x_prompt = nrm((BATCH, SEQ, D_MODEL), 1.0)
    x_sample = nrm((DEC_BATCH, DEC_SEQ, D_MODEL), 1.0)
    state_gla = nrm((DEPTH, DEC_BATCH, GLA_HEADS, GLA_HK, GLA_HV), 0.1)
    state_lru_h = nrm((DEPTH, DEC_BATCH, LRU_WIDTH), 0.5)
    state_lru_conv = nrm((DEPTH, DEC_BATCH, CONV_WIDTH - 1, LRU_WIDTH), 1.0)
    state_rwkv = nrm((DEPTH, DEC_BATCH, RWKV_HEADS, RWKV_HD, RWKV_HD), 0.1)
    state_rwkv_shift = nrm((DEPTH, DEC_BATCH, SHIFT_WIDTH), 1.0)
    norm_g = 1.0 + nrm((DEPTH, D_MODEL), 0.02)
    w_in = nrm((DEPTH, D_MODEL, D_IN), D_MODEL ** -0.5)
    gla_w_gup = nrm((DEPTH, GLA_RANK, GLA_DK), GLA_RANK ** -0.5)
    gla_b_g = 1.0 + nrm((DEPTH, GLA_DK), 0.1)
    gla_norm_g = 1.0 + nrm((DEPTH, GLA_DV), 0.02)
    lru_conv_w = nrm((DEPTH, CONV_WIDTH, LRU_WIDTH), CONV_WIDTH ** -0.5)
    lru_conv_b = nrm((DEPTH, LRU_WIDTH), 0.01)
    lru_w_a = nrm((DEPTH, LRU_BLOCKS, LRU_BS, LRU_BS), LRU_BS ** -0.5)
    lru_b_a = nrm((DEPTH, LRU_WIDTH), 0.01)
    lru_w_x = nrm((DEPTH, LRU_BLOCKS, LRU_BS, LRU_BS), LRU_BS ** -0.5)
    lru_b_x = nrm((DEPTH, LRU_WIDTH), 0.01)
    s = unif((DEPTH, LRU_WIDTH), 0.9, 0.999) ** (1.0 / LRU_C)
    lru_lambda = jnp.log(s) - jnp.log1p(-s)
    rwkv_mu = unif((DEPTH, SHIFT_WIDTH), 0.0, 1.0)
    rwkv_w0 = unif((DEPTH, RWKV_WIDTH), -6.0, -1.0)
    rwkv_w_up = nrm((DEPTH, DECAY_RANK, RWKV_WIDTH), 0.1 * DECAY_RANK ** -0.5)
    rwkv_a0 = nrm((DEPTH, RWKV_WIDTH), 0.1)
    rwkv_a_up = nrm((DEPTH, AAA_RANK, RWKV_WIDTH), AAA_RANK ** -0.5)
    rwkv_k_k = 0.85 + nrm((DEPTH, RWKV_WIDTH), 0.02)
    rwkv_k_a = 1.0 + nrm((DEPTH, RWKV_WIDTH), 0.02)
    rwkv_r_k = nrm((DEPTH, RWKV_HEADS, RWKV_HD), 0.1)
    rwkv_gn_w = 1.0 + nrm((DEPTH, RWKV_WIDTH), 0.02)
    rwkv_gn_b = nrm((DEPTH, RWKV_WIDTH), 0.01)
    w_proj_gla = nrm((DEPTH, GLA_DV, D_MODEL), GLA_DV ** -0.5)
    w_proj_lru = nrm((DEPTH, LRU_WIDTH, D_MODEL), LRU_WIDTH ** -0.5)
    w_proj_rwkv = nrm((DEPTH, RWKV_WIDTH, D_MODEL), RWKV_WIDTH ** -0.5)
    w_out = nrm((DEPTH, D_MODEL, D_MODEL), D_MODEL ** -0.5)
    final_norm_g = 1.0 + nrm((D_MODEL,), 0.02)
    return {
        'x_prompt': x_prompt, 'x_sample': x_sample,
        'state_gla': state_gla, 'state_lru_h': state_lru_h, 'state_lru_conv': state_lru_conv,
        'state_rwkv': state_rwkv, 'state_rwkv_shift': state_rwkv_shift,
        'norm_g': norm_g, 'w_in': w_in,
        'gla_w_gup': gla_w_gup, 'gla_b_g': gla_b_g, 'gla_norm_g': gla_norm_g,
        'lru_conv_w': lru_conv_w, 'lru_conv_b': lru_conv_b, 'lru_w_a': lru_w_a, 'lru_b_a': lru_b_a,
        'lru_w_x': lru_w_x, 'lru_b_x': lru_b_x, 'lru_lambda': lru_lambda,
        'rwkv_mu': rwkv_mu, 'rwkv_w0': rwkv_w0, 'rwkv_w_up': rwkv_w_up, 'rwkv_a0': rwkv_a0,
        'rwkv_a_up': rwkv_a_up, 'rwkv_k_k': rwkv_k_k, 'rwkv_k_a': rwkv_k_a, 'rwkv_r_k': rwkv_r_k,
        'rwkv_gn_w': rwkv_gn_w, 'rwkv_gn_b': rwkv_gn_b,
        'w_proj_gla': w_proj_gla, 'w_proj_lru': w_proj_lru, 'w_proj_rwkv': w_proj_rwkv,
        'w_out': w_out, 'final_norm_g': final_norm_g,
    }


def reference(x_prompt, x_sample, state_gla, state_lru_h, state_lru_conv, state_rwkv, state_rwkv_shift,
              norm_g, w_in, gla_w_gup, gla_b_g, gla_norm_g,
              lru_conv_w, lru_conv_b, lru_w_a, lru_b_a, lru_w_x, lru_b_x, lru_lambda,
              rwkv_mu, rwkv_w0, rwkv_w_up, rwkv_a0, rwkv_a_up, rwkv_k_k, rwkv_k_a, rwkv_r_k,
              rwkv_gn_w, rwkv_gn_b, w_proj_gla, w_proj_lru, w_proj_rwkv, w_out, final_norm_g):
    P = dict(norm_g=norm_g, w_in=w_in, gla_w_gup=gla_w_gup, gla_b_g=gla_b_g, gla_norm_g=gla_norm_g,
             lru_conv_w=lru_conv_w, lru_conv_b=lru_conv_b, lru_w_a=lru_w_a, lru_b_a=lru_b_a,
             lru_w_x=lru_w_x, lru_b_x=lru_b_x, lru_lambda=lru_lambda,
             rwkv_mu=rwkv_mu, rwkv_w0=rwkv_w0, rwkv_w_up=rwkv_w_up, rwkv_a0=rwkv_a0,
             rwkv_a_up=rwkv_a_up, rwkv_k_k=rwkv_k_k, rwkv_k_a=rwkv_k_a, rwkv_r_k=rwkv_r_k,
             rwkv_gn_w=rwkv_gn_w, rwkv_gn_b=rwkv_gn_b, w_proj_gla=w_proj_gla, w_proj_lru=w_proj_lru,
             w_proj_rwkv=w_proj_rwkv, w_out=w_out, final_norm_g=final_norm_g)
    dt = x_prompt.dtype
    B = x_prompt.shape[0]
    gla0 = jnp.zeros((DEPTH, B, GLA_HEADS, GLA_HK, GLA_HV), dt)
    h0 = jnp.zeros((DEPTH, B, LRU_WIDTH), dt)
    conv0 = jnp.zeros((DEPTH, B, CONV_WIDTH - 1, LRU_WIDTH), dt)
    rw0 = jnp.zeros((DEPTH, B, RWKV_HEADS, RWKV_HD, RWKV_HD), dt)
    sh0 = jnp.zeros((DEPTH, B, SHIFT_WIDTH), dt)
    y_prompt, gla_p, lru_h_p, lru_conv_p, rwkv_p, rwkv_shift_p = run_trunk(
        x_prompt, gla0, h0, conv0, rw0, sh0, P)
    y_sample, gla_s, lru_h_s, lru_conv_s, rwkv_s, rwkv_shift_s = run_trunk(
        x_sample, state_gla, state_lru_h, state_lru_conv, state_rwkv, state_rwkv_shift, P)
    return (y_prompt, y_sample,
            gla_p, lru_h_p, lru_conv_p, rwkv_p, rwkv_shift_p,
            gla_s, lru_h_s, lru_conv_s, rwkv_s, rwkv_shift_s)
```

```cpp
#include <hip/hip_runtime.h>
#include <hip/hip_cooperative_groups.h>
#include <cstdio>
namespace cg = cooperative_groups;

typedef unsigned short u16;
typedef __attribute__((ext_vector_type(8))) short bf16x8;
typedef __attribute__((ext_vector_type(4))) float f32x4;

#ifndef PROBE_DUP
#define PROBE_DUP 0
#endif
#ifndef MULTI_LAUNCH
#define MULTI_LAUNCH 0
#endif

constexpr int NTOK = 16640;
constexpr int NPT = 16384;
constexpr int DM = 1024;
constexpr int DIN = 12432;
constexpr int LDY = 6400;
constexpr int YQ = 0, YK = 512, YV = 1024, YGD = 2048, YXL = 2176, YRW = 3200;
constexpr int NMT = 130;
constexpr int NGJOB = 1056;

constexpr long O_YP = 0, O_YS = 16777216, O_GLAP = 17039360, O_LHP = 19136512, O_LCP = 19152896,
               O_RWP = 19202048, O_RSP = 20250624, O_GLAS = 20301824, O_LHS = 24496128, O_LCS = 24528896,
               O_RWS = 24627200, O_RSS = 26724352;

constexpr size_t al256(size_t x) { return (x + 255) & ~(size_t)255; }
constexpr size_t WS_X = 4096;
constexpr size_t WS_XN = al256(WS_X + (size_t)NTOK * DM * 4);
constexpr size_t WS_Y = al256(WS_XN + (size_t)NTOK * DM * 2);
constexpr size_t WS_WTIN = al256(WS_Y + (size_t)NTOK * LDY * 2 + 65536);
constexpr size_t WS_WTP = al256(WS_WTIN + (size_t)12544 * 1024 * 2);
constexpr size_t WS_WTLRU = al256(WS_WTP + (size_t)16 * 1024 * 1024 * 2);
constexpr size_t WS_WTRW = al256(WS_WTLRU + (size_t)4 * 2 * 8 * 16384 * 2);
constexpr size_t WS_OG = al256(WS_WTRW + (size_t)4 * 2 * 65536 * 2);
constexpr size_t WS_OL = al256(WS_OG + (size_t)NTOK * DM * 2);
constexpr size_t WS_OR = al256(WS_OL + (size_t)NTOK * DM * 2);
constexpr size_t WS_XC = al256(WS_OR + (size_t)NTOK * DM * 2);
constexpr size_t WS_GST = al256(WS_XC + (size_t)NTOK * DM * 2);
constexpr size_t WS_GDEC = al256(WS_GST + (size_t)NGJOB * 32768 * 2);
constexpr size_t WS_LLA = al256(WS_GDEC + (size_t)NGJOB * 128 * 4);
constexpr size_t WS_LVV = al256(WS_LLA + (size_t)NTOK * DM * 2);
constexpr size_t WS_LCH = al256(WS_LVV + (size_t)NTOK * DM * 2);
constexpr size_t WS_RWW = al256(WS_LCH + (size_t)256 * 1024 * 2 * 4);
constexpr size_t WS_RWA = al256(WS_RWW + (size_t)NTOK * DM * 4);
constexpr size_t WS_RT = al256(WS_RWA + (size_t)NTOK * DM * 2);
constexpr size_t WS_CSP = al256(WS_RT + (size_t)NTOK * 128 * 2);
constexpr size_t WS_CTL = al256(WS_CSP + 4096 * 4);
constexpr int CTL_CLAIM = 0;
constexpr int CTL_QP = 8 * 4096;
constexpr int CTL_QS = CTL_QP + 8;
constexpr int CTL_QG = CTL_QS + 8;
constexpr int CTL_ROLE = CTL_QG + 64;
constexpr int CTL_NCU = CTL_ROLE + 8 * 4096;
constexpr int CTL_WORDS = CTL_NCU + 8;
constexpr size_t WS_BAR = al256(WS_CTL + (size_t)CTL_WORDS * 4);
constexpr int HB_WORDS = 64 * 50;
constexpr size_t WS_END = al256(WS_BAR + (size_t)HB_WORDS * 4);

struct Params {
  const float* in[34];
  float* out;
  unsigned char* ws;
  int ph0, ph1;
};

struct Ctx { int tid, bid, nb; unsigned char* ws; float* out; };
#define TID (cx.tid)
#define BID (cx.bid)
#define NBLK (cx.nb)
extern __shared__ __attribute__((aligned(16))) unsigned char smem[];
constexpr int SMEM_CTL = 72 * 1024;
constexpr int SMEM_BYTES = SMEM_CTL + 64;

__device__ __forceinline__ u16 f2bf(float f) {
  unsigned u = __float_as_uint(f);
  u += 0x7fffu + ((u >> 16) & 1u);
  return (u16)(u >> 16);
}
__device__ __forceinline__ float bf2f(u16 h) { return __uint_as_float(((unsigned)h) << 16); }
__device__ __forceinline__ float sigmoidf_(float x) { return 1.f / (1.f + __expf(-x)); }
__device__ __forceinline__ float siluf_(float x) { return x / (1.f + __expf(-x)); }
__device__ __forceinline__ float logsigmoidf_(float x) { return fminf(x, 0.f) - __logf(1.f + __expf(-fabsf(x))); }

__device__ __forceinline__ float dppf(float x, const int ctrl) {
  return x;
}
#define DPP_ADD(x, ctrl) x += __int_as_float(__builtin_amdgcn_update_dpp(0, __float_as_int(x), ctrl, 0xF, 0xF, true))
__device__ __forceinline__ float row16_allsum(float x) {
  DPP_ADD(x, 0xB1);
  DPP_ADD(x, 0x4E);
  DPP_ADD(x, 0x141);
  DPP_ADD(x, 0x140);
  return x;
}
__device__ __forceinline__ float wave_allsum(float x) {
#pragma unroll
  for (int o = 32; o >= 1; o >>= 1) x += __shfl_xor(x, o);
  return x;
}

__device__ __forceinline__ void gemm_mainloop(const Ctx& cx, f32x4 (&acc)[4][4], const u16* Ag, int lda, const u16* Bg, int ldb, int K) {
  const int tid = TID, wid = tid >> 6, lane = tid & 63, wr = wid >> 1, wc = wid & 1, fr = lane & 15, fq = lane >> 4;
  const int nk = K >> 6;
  const int lr0 = tid >> 3, lc = ((tid & 7) ^ ((tid >> 4) & 7)) * 8;
  const u16* ga = Ag + (long)lr0 * lda + lc;
  const u16* gb = Bg + (long)lr0 * ldb + lc;
  const int swz = (fr >> 1) & 7;
#define G_ISSUE(kt_, buf_)                                                                                                   \
  {                                                                                                                          \
    unsigned char* d_ = smem + (buf_) * 32768 + tid * 16;                                                                    \
    _Pragma("unroll") for (int i = 0; i < 4; ++i) {                                                                          \
      __builtin_amdgcn_global_load_lds((const unsigned*)(ga + (long)(i * 32) * lda + (kt_) * 64),                            \
                                       (__attribute__((address_space(3))) unsigned*)(d_ + i * 4096), 16, 0, 0);              \
      __builtin_amdgcn_global_load_lds((const unsigned*)(gb + (long)(i * 32) * ldb + (kt_) * 64),                            \
                                       (__attribute__((address_space(3))) unsigned*)(d_ + 16384 + i * 4096), 16, 0, 0);      \
    }                                                                                                                        \
  }
  G_ISSUE(0, 0)
  asm volatile("s_waitcnt vmcnt(0)" ::: "memory");
  __syncthreads();
  for (int kt = 0; kt < nk; ++kt) {
    if (kt + 1 < nk) G_ISSUE(kt + 1, (kt + 1) & 1)
    const unsigned char* SA = smem + (kt & 1) * 32768;
    const unsigned char* SB = SA + 16384;
#pragma unroll
    for (int ks = 0; ks < 2; ++ks) {
      const int co = ((ks * 4 + fq) ^ swz) * 16;
      bf16x8 At[4], Bt[4];
#pragma unroll
      for (int m = 0; m < 4; ++m) At[m] = *(const bf16x8*)(SA + (wr * 64 + m * 16 + fr) * 128 + co);
#pragma unroll
      for (int n = 0; n < 4; ++n) Bt[n] = *(const bf16x8*)(SB + (wc * 64 + n * 16 + fr) * 128 + co);
#pragma unroll
      for (int m = 0; m < 4; ++m)
#pragma unroll
        for (int n = 0; n < 4; ++n) acc[m][n] = __builtin_amdgcn_mfma_f32_16x16x32_bf16(Bt[n], At[m], acc[m][n], 0, 0, 0);
    }
    asm volatile("s_waitcnt vmcnt(0)" ::: "memory");
    __syncthreads();
  }
#undef G_ISSUE
}
__device__ __forceinline__ void gemm_mainloop3(const Ctx& cx, f32x4 (&acc)[5][4], const u16* Ag, int lda, const u16* Bg, int ldb, int K) {
  const int tid = TID, wid = tid >> 6, lane = tid & 63, wr = wid >> 1, wc = wid & 1, fr = lane & 15, fq = lane >> 4;
  const int nk = K >> 6;
  const int lr0 = tid >> 3, lc = ((tid & 7) ^ ((tid >> 4) & 7)) * 8;
  const u16* ga = Ag + (long)lr0 * lda + lc;
  const u16* gb = Bg + (long)lr0 * ldb + lc;
  const int swz = (fr >> 1) & 7;
#define G3_ISSUE(kt_, buf_)                                                                                                  \
  {                                                                                                                          \
    unsigned char* d_ = smem + (buf_) * 36864 + tid * 16;                                                                    \
    _Pragma("unroll") for (int i = 0; i < 5; ++i)                                                                            \
      __builtin_amdgcn_global_load_lds((const unsigned*)(ga + (long)(i * 32) * lda + (kt_) * 64),                            \
                                       (__attribute__((address_space(3))) unsigned*)(d_ + i * 4096), 16, 0, 0);              \
    _Pragma("unroll") for (int i = 0; i < 4; ++i)                                                                            \
      __builtin_amdgcn_global_load_lds((const unsigned*)(gb + (long)(i * 32) * ldb + (kt_) * 64),                            \
                                       (__attribute__((address_space(3))) unsigned*)(d_ + 20480 + i * 4096), 16, 0, 0);      \
  }
  G3_ISSUE(0, 0)
  asm volatile("s_waitcnt vmcnt(0)" ::: "memory");
  __syncthreads();
  for (int kt = 0; kt < nk; ++kt) {
    if (kt + 1 < nk) G3_ISSUE(kt + 1, (kt + 1) & 1)
    const unsigned char* SA = smem + (kt & 1) * 36864;
    const unsigned char* SB = SA + 20480;
#pragma unroll
    for (int ks = 0; ks < 2; ++ks) {
      const int co = ((ks * 4 + fq) ^ swz) * 16;
      bf16x8 At[5], Bt[4];
#pragma unroll
      for (int m = 0; m < 5; ++m) At[m] = *(const bf16x8*)(SA + (wr * 80 + m * 16 + fr) * 128 + co);
#pragma unroll
      for (int n = 0; n < 4; ++n) Bt[n] = *(const bf16x8*)(SB + (wc * 64 + n * 16 + fr) * 128 + co);
#pragma unroll
      for (int m = 0; m < 5; ++m)
#pragma unroll
        for (int n = 0; n < 4; ++n) acc[m][n] = __builtin_amdgcn_mfma_f32_16x16x32_bf16(Bt[n], At[m], acc[m][n], 0, 0, 0);
    }
    asm volatile("s_waitcnt vmcnt(0)" ::: "memory");
    __syncthreads();
  }
#undef G3_ISSUE
}
__device__ __forceinline__ void acc_zero5(f32x4 (&acc)[5][4]) {
#pragma unroll
  for (int m = 0; m < 5; ++m)
#pragma unroll
    for (int n = 0; n < 4; ++n) acc[m][n] = (f32x4){0.f, 0.f, 0.f, 0.f};
}
#define EPI5_BEGIN                                                                                          \
  {                                                                                                         \
    int e_z = 0; asm volatile("" : "+v"(e_z));                                                              \
    const int e_tid = TID + e_z, e_wid = e_tid >> 6, e_lane = e_tid & 63, e_wr = e_wid >> 1, e_wc = e_wid & 1, \
              e_fr = e_lane & 15, e_fq = e_lane >> 4;                                                       \
    _Pragma("unroll") for (int m = 0; m < 5; ++m) { __builtin_amdgcn_sched_barrier(0);                      \
      _Pragma("unroll") for (int n = 0; n < 4; ++n) {                                                       \
      const int lrow = e_wr * 80 + m * 16 + e_fr;                                                           \
      const int lcol = e_wc * 64 + n * 16 + e_fq * 4;                                                       \
      const f32x4 v = acc[m][n];
#define EPI5_END \
  }              \
  }              \
  }
constexpr int NMT3 = 104;
__device__ __forceinline__ void acc_zero(f32x4 (&acc)[4][4]) {
#pragma unroll
  for (int m = 0; m < 4; ++m)
#pragma unroll
    for (int n = 0; n < 4; ++n) acc[m][n] = (f32x4){0.f, 0.f, 0.f, 0.f};
}
#define EPI4_BEGIN                                                                                          \
  {                                                                                                         \
    int e_z = 0; asm volatile("" : "+v"(e_z));                                                              \
    const int e_tid = TID + e_z, e_wid = e_tid >> 6, e_lane = e_tid & 63, e_wr = e_wid >> 1, e_wc = e_wid & 1, \
              e_fr = e_lane & 15, e_fq = e_lane >> 4;                                                       \
    _Pragma("unroll") for (int m = 0; m < 4; ++m) { __builtin_amdgcn_sched_barrier(0);                      \
      _Pragma("unroll") for (int n = 0; n < 4; ++n) {                                                       \
      const int lrow = e_wr * 64 + m * 16 + e_fr;                                                           \
      const int lcol = e_wc * 64 + n * 16 + e_fq * 4;                                                       \
      const f32x4 v = acc[m][n];
#define EPI4_END \
  }              \
  }              \
  }
__device__ __forceinline__ ushort4 pack4(float a, float b, float c, float d) {
  ushort4 o; o.x = f2bf(a); o.y = f2bf(b); o.z = f2bf(c); o.w = f2bf(d); return o;
}

__device__ __forceinline__ void tok_decode(int tok, int& seq, int& pos, int& L) {
  if (tok < NPT) { seq = tok >> 12; pos = tok & 4095; L = 4096; }
  else { int t = tok - NPT; seq = 4 + (t >> 5); pos = t & 31; L = 32; }
}

__device__ __forceinline__ void tconv(const Ctx& cx, const float* __restrict__ src, int K, int N, u16* __restrict__ dst) {
  const int items = N * (K >> 3);
  for (int it = BID * 256 + TID; it < items; it += NBLK * 256) {
    int n = it % N, k8 = it / N;
    bf16x8 v;
#pragma unroll
    for (int j = 0; j < 8; ++j) v[j] = (short)f2bf(src[(long)(k8 * 8 + j) * N + n]);
    *(bf16x8*)(dst + (long)n * K + k8 * 8) = v;
  }
}

__device__ __forceinline__ void phase_convw(const Ctx& cx, const Params& p) {
  u16* WTP = (u16*)(cx.ws + WS_WTP);
  u16* WTLRU = (u16*)(cx.ws + WS_WTLRU);
  u16* WTRW = (u16*)(cx.ws + WS_WTRW);
  for (int it = BID * 256 + TID; it < CTL_WORDS; it += NBLK * 256) ((int*)(cx.ws + WS_CTL))[it] = 0;
  for (int it = BID * 256 + TID; it < HB_WORDS; it += NBLK * 256) ((unsigned*)(cx.ws + WS_BAR))[it] = 0u;
  for (int it = BID * 256 + TID; it < 4096; it += NBLK * 256) {
    const float nl = -p.in[18][it];
    ((float*)(cx.ws + WS_CSP))[it] = -8.f * (fmaxf(nl, 0.f) + log1pf(__expf(-fabsf(nl))));
  }
  for (int l = 0; l < 4; ++l) {
    tconv(cx, p.in[29] + (long)l * 1048576, 1024, 1024, WTP + (long)(l * 4 + 0) * 1048576);
    tconv(cx, p.in[30] + (long)l * 1048576, 1024, 1024, WTP + (long)(l * 4 + 1) * 1048576);
    tconv(cx, p.in[31] + (long)l * 1048576, 1024, 1024, WTP + (long)(l * 4 + 2) * 1048576);
    tconv(cx, p.in[32] + (long)l * 1048576, 1024, 1024, WTP + (long)(l * 4 + 3) * 1048576);
    for (int n = 0; n < 8; ++n) {
      tconv(cx, p.in[14] + (long)(l * 8 + n) * 16384, 128, 128, WTLRU + (long)((l * 2 + 0) * 8 + n) * 16384);
      tconv(cx, p.in[16] + (long)(l * 8 + n) * 16384, 128, 128, WTLRU + (long)((l * 2 + 1) * 8 + n) * 16384);
    }
    tconv(cx, p.in[21] + (long)l * 65536, 64, 1024, WTRW + (long)(l * 2 + 0) * 65536);
    tconv(cx, p.in[23] + (long)l * 65536, 64, 1024, WTRW + (long)(l * 2 + 1) * 65536);
  }
}

__device__ __forceinline__ void phase_norm(const Ctx& cx, const Params& p, int l) {
  float* X = (float*)(cx.ws + WS_X);
  u16* XN = (u16*)(cx.ws + WS_XN);
  const int lane = TID & 63;
  const float* g = (l < 4) ? (p.in[7] + l * 1024) : p.in[33];
  for (int row = BID * 4 + (TID >> 6); row < NTOK; row += NBLK * 4) {
    const float* src = (l == 0) ? (row < NPT ? p.in[0] + (long)row * 1024 : p.in[1] + (long)(row - NPT) * 1024) : X + (long)row * 1024;
    float4 v[4];
    float ss = 0.f;
#pragma unroll
    for (int i = 0; i < 4; ++i) {
      v[i] = ((const float4*)src)[lane + 64 * i];
      ss += v[i].x * v[i].x + v[i].y * v[i].y + v[i].z * v[i].z + v[i].w * v[i].w;
    }
    ss = wave_allsum(ss);
    const float r = rsqrtf(ss * (1.f / 1024.f) + 1e-6f);
#pragma unroll
    for (int i = 0; i < 4; ++i) {
      const int c = (lane + 64 * i) * 4;
      float4 gg = *(const float4*)(g + c);
      float4 o;
      o.x = v[i].x * r * gg.x; o.y = v[i].y * r * gg.y; o.z = v[i].z * r * gg.z; o.w = v[i].w * r * gg.w;
      if (l == 0) ((float4*)(X + (long)row * 1024))[lane + 64 * i] = v[i];
      if (l < 4) {
        ushort4 ob;
        ob.x = f2bf(o.x); ob.y = f2bf(o.y); ob.z = f2bf(o.z); ob.w = f2bf(o.w);
        *(ushort4*)(XN + (long)row * 1024 + c) = ob;
      } else {
        float* dst = (row < NPT) ? (cx.out + O_YP + (long)row * 1024) : (cx.out + O_YS + (long)(row - NPT) * 1024);
        *(float4*)(dst + c) = o;
      }
    }
  }
  if (l < 4) {
    const float* W = p.in[8] + (long)l * 1024 * DIN;
    u16* WT = (u16*)(cx.ws + WS_WTIN);
    const int items = 12544 * 128;
    for (int it = BID * 256 + TID; it < items; it += NBLK * 256) {
      int n = it % 12544, k8 = it / 12544;
      int sc;
      if (n < 6400) {
        if (n < 2064) sc = n;
        else if (n < 2176) sc = -1;
        else if (n < 3200) sc = 3088 + (n - 2176);
        else sc = 5136 + (n - 3200);
      } else {
        int q = n - 6400;
        if (q < 1024) sc = 2064 + q;
        else if (q < 2048) sc = 4112 + (q - 1024);
        else if (q < 3072) sc = 8336 + (q - 2048);
        else sc = 9360 + (q - 3072);
      }
      bf16x8 v;
#pragma unroll
      for (int j = 0; j < 8; ++j) v[j] = (sc >= 0) ? (short)f2bf(W[(long)(k8 * 8 + j) * DIN + sc]) : (short)0;
      *(bf16x8*)(WT + (long)n * 1024 + k8 * 8) = v;
    }
  }
}

#define TILE_LOOP_BEGIN(NT_)                                                                \
  {                                                                                         \
    const int tl_total = NMT * (NT_), tl_per = NBLK >> 3, tl_x = BID & 7, tl_l = BID >> 3;  \
    const int tl_full = (NT_) >> 3;                                                         \
    for (int tl_it = 0;; ++tl_it) {                                                         \
      const int tl_base = (tl_it * 8 + tl_x) * tl_per;                                      \
      if (tl_it * 8 * tl_per >= tl_total) break;                                            \
      const int t = tl_base + tl_l;                                                         \
      if (t >= tl_total) continue;                                                          \
      int mt, nt;                                                                           \
      if (t < tl_full * (NMT * 8)) { const int sn = t / (NMT * 8), r = t % (NMT * 8); mt = r >> 3; nt = sn * 8 + (r & 7); } \
      else { const int r = t - tl_full * (NMT * 8), wn = (NT_) - tl_full * 8; mt = r / wn; nt = tl_full * 8 + r % wn; }
#define TILE3_LOOP_BEGIN(NT_)                                                                \
  {                                                                                         \
    const int tl_total = NMT3 * (NT_), tl_per = NBLK >> 3, tl_x = BID & 7, tl_l = BID >> 3;  \
    const int tl_full = (NT_) >> 3;                                                         \
    for (int tl_it = 0;; ++tl_it) {                                                         \
      const int tl_base = (tl_it * 8 + tl_x) * tl_per;                                      \
      if (tl_it * 8 * tl_per >= tl_total) break;                                            \
      const int t = tl_base + tl_l;                                                         \
      if (t >= tl_total) continue;                                                          \
      int mt, nt;                                                                           \
      if (t < tl_full * (NMT3 * 8)) { const int sn = t / (NMT3 * 8), r = t % (NMT3 * 8); mt = r >> 3; nt = sn * 8 + (r & 7); } \
      else { const int r = t - tl_full * (NMT3 * 8), wn = (NT_) - tl_full * 8; mt = r / wn; nt = tl_full * 8 + r % wn; }
#define TILE_LOOP_END \
    }                 \
  }

__device__ __forceinline__ void phase_inproj1(const Ctx& cx, const Params& p) {
  const u16* XN = (const u16*)(cx.ws + WS_XN);
  const u16* WT = (const u16*)(cx.ws + WS_WTIN);
  u16* Y = (u16*)(cx.ws + WS_Y);
  TILE_LOOP_BEGIN(50)
    f32x4 acc[4][4];
    acc_zero(acc);
    gemm_mainloop(cx, acc, XN + (long)mt * 128 * 1024, 1024, WT + (long)nt * 128 * 1024, 1024, 1024);
    EPI4_BEGIN
      *(ushort4*)(Y + (long)(mt * 128 + lrow) * LDY + nt * 128 + lcol) = pack4(v[0], v[1], v[2], v[3]);
    EPI4_END
  TILE_LOOP_END
}

__device__ __forceinline__ void phase_prep(const Ctx& cx, const Params& p, int l) {
  const u16* __restrict__ Y = (const u16*)(cx.ws + WS_Y);
  u16* __restrict__ XC = (u16*)(cx.ws + WS_XC);
  u16* __restrict__ RT = (u16*)(cx.ws + WS_RT);
  const int gtid = BID * 256 + TID, gstr = NBLK * 256;
  const float* cw = p.in[12] + l * 4096;
  const float* cb = p.in[13] + l * 1024;
#pragma unroll 2
  for (int it = gtid; it < NTOK * 128; it += gstr) {
    const int tok = it >> 7, c = (it & 127) * 8;
    int seq, pos, L;
    tok_decode(tok, seq, pos, L);
    float a[8], cur[8];
    {
      const float4 b0 = *(const float4*)(cb + c), b1 = *(const float4*)(cb + c + 4);
      a[0] = b0.x; a[1] = b0.y; a[2] = b0.z; a[3] = b0.w; a[4] = b1.x; a[5] = b1.y; a[6] = b1.z; a[7] = b1.w;
    }
#pragma unroll
    for (int t = 0; t < 4; ++t) {
      const int pp = pos - 3 + t;
      float x[8];
      if (pp >= 0) {
        const bf16x8 xv = *(const bf16x8*)(Y + (long)(tok - 3 + t) * LDY + YXL + c);
#pragma unroll
        for (int j = 0; j < 8; ++j) x[j] = bf2f((u16)xv[j]);
      } else if (seq >= 4) {
        const float* s_ = p.in[4] + ((long)((l * 8 + (seq - 4)) * 3 + (pos + t))) * 1024 + c;
#pragma unroll
        for (int j = 0; j < 8; ++j) x[j] = s_[j];
      } else {
#pragma unroll
        for (int j = 0; j < 8; ++j) x[j] = 0.f;
      }
      const float4 w0 = *(const float4*)(cw + t * 1024 + c), w1 = *(const float4*)(cw + t * 1024 + c + 4);
      a[0] += w0.x * x[0]; a[1] += w0.y * x[1]; a[2] += w0.z * x[2]; a[3] += w0.w * x[3];
      a[4] += w1.x * x[4]; a[5] += w1.y * x[5]; a[6] += w1.z * x[6]; a[7] += w1.w * x[7];
      if (t == 3) {
#pragma unroll
        for (int j = 0; j < 8; ++j) cur[j] = x[j];
      }
    }
    bf16x8 o;
#pragma unroll
    for (int j = 0; j < 8; ++j) o[j] = (short)f2bf(a[j]);
    *(bf16x8*)(XC + (long)tok * 1024 + c) = o;
    if (pos >= L - 3) {
      const int jj = pos - (L - 3);
      float* dst = (seq < 4) ? (cx.out + O_LCP + ((long)((l * 4 + seq) * 3 + jj)) * 1024 + c)
                             : (cx.out + O_LCS + ((long)((l * 8 + (seq - 4)) * 3 + jj)) * 1024 + c);
      *(float4*)dst = make_float4(cur[0], cur[1], cur[2], cur[3]);
      *(float4*)(dst + 4) = make_float4(cur[4], cur[5], cur[6], cur[7]);
    }
  }
  const float* mu = p.in[19] + l * 3200;
#pragma unroll 2
  for (int it = gtid; it < NTOK * 16; it += gstr) {
    const int tok = it >> 4, c = (it & 15) * 8;
    int seq, pos, L;
    tok_decode(tok, seq, pos, L);
    const bf16x8 cv = *(const bf16x8*)(Y + (long)tok * LDY + YRW + 3072 + c);
    float prev[8];
    if (pos > 0) {
      const bf16x8 pv = *(const bf16x8*)(Y + (long)(tok - 1) * LDY + YRW + 3072 + c);
#pragma unroll
      for (int j = 0; j < 8; ++j) prev[j] = bf2f((u16)pv[j]);
    } else if (seq >= 4) {
      const float* s_ = p.in[6] + (long)(l * 8 + (seq - 4)) * 3200 + 3072 + c;
#pragma unroll
      for (int j = 0; j < 8; ++j) prev[j] = s_[j];
    } else {
#pragma unroll
      for (int j = 0; j < 8; ++j) prev[j] = 0.f;
    }
    const float4 m0 = *(const float4*)(mu + 3072 + c), m1 = *(const float4*)(mu + 3072 + c + 4);
    const float mm[8] = {m0.x, m0.y, m0.z, m0.w, m1.x, m1.y, m1.z, m1.w};
    bf16x8 o;
#pragma unroll
    for (int j = 0; j < 8; ++j) {
      const float cur = bf2f((u16)cv[j]);
      const float xs = cur + (prev[j] - cur) * mm[j];
      const float th = 1.f - 2.f / (__expf(2.f * xs) + 1.f);
      o[j] = (short)f2bf(c < 64 ? th : xs);
    }
    *(bf16x8*)(RT + (long)tok * 128 + c) = o;
  }
  for (int it = gtid; it < 12 * 3200; it += gstr) {
    const int seq = it / 3200, c = it % 3200;
    const int last = (seq < 4) ? (seq * 4096 + 4095) : (NPT + (seq - 4) * 32 + 31);
    const float v = bf2f(Y[(long)last * LDY + YRW + c]);
    if (seq < 4) cx.out[O_RSP + (long)(l * 4 + seq) * 3200 + c] = v;
    else cx.out[O_RSS + (long)(l * 8 + (seq - 4)) * 3200 + c] = v;
  }
}

__device__ __forceinline__ void gla_job_decode(int job, int& seq, int& h, int& tok0, int& valid) {
  if (job < 1024) { seq = job >> 8; int rem = job & 255; h = rem & 3; tok0 = seq * 4096 + (rem >> 2) * 64; valid = 64; }
  else { int j = job - 1024; seq = 4 + (j >> 2); h = j & 3; tok0 = NPT + (seq - 4) * 32; valid = 32; }
}
constexpr int G_SGD = 0;
constexpr int G_SHT = 4096;
constexpr int G_SSS = 5120;
constexpr int G_QD = 6144;
constexpr int G_KN = G_QD + 17408;
constexpr int G_P = G_KN + 17408;
constexpr int GS = 136, PS = 72;

#define GLA_LA(i_, valid_)                                                                       \
  ({                                                                                             \
    float x_ = g_bg;                                                                             \
    _Pragma("unroll") for (int r4 = 0; r4 < 4; ++r4) {                                           \
      const float4 gv = *(const float4*)(sGD + (i_) * 16 + r4 * 4);                              \
      x_ += gv.x * g_wg[r4 * 4] + gv.y * g_wg[r4 * 4 + 1] + gv.z * g_wg[r4 * 4 + 2] + gv.w * g_wg[r4 * 4 + 3]; \
    }                                                                                            \
    float la_ = logsigmoidf_(x_) * (1.f / 16.f);                                                 \
    if ((i_) >= (valid_)) la_ = 0.f;                                                             \
    la_;                                                                                         \
  })
#define GLA_CUMSUM(l_, h_, tok0_, valid_)                                                                          \
  const int g_tid = TID, g_d = g_tid & 127, g_half = g_tid >> 7;                                                    \
  float* sGD = (float*)(smem + G_SGD);                                                                              \
  float* sHT = (float*)(smem + G_SHT);                                                                              \
  {                                                                                                                 \
    _Pragma("unroll") for (int q = 0; q < 4; ++q) {                                                                 \
      const int idx = g_tid * 4 + q, i = idx >> 4, r = idx & 15;                                                    \
      const int ti = (i < valid_) ? i : (valid_ - 1);                                                               \
      sGD[idx] = bf2f(Y[(long)(tok0_ + ti) * LDY + YGD + r]);                                                       \
    }                                                                                                               \
  }                                                                                                                 \
  float g_wg[16];                                                                                                   \
  _Pragma("unroll") for (int r = 0; r < 16; ++r) g_wg[r] = p.in[9][(long)(l_ * 16 + r) * 512 + h_ * 128 + g_d];      \
  const float g_bg = p.in[10][l_ * 512 + h_ * 128 + g_d];                                                           \
  __syncthreads();                                                                                                  \
  {                                                                                                                 \
    float run = 0.f;                                                                                                \
    _Pragma("unroll 2") for (int ii = 0; ii < 32; ++ii) run += GLA_LA(g_half * 32 + ii, valid_);                    \
    sHT[g_half * 128 + g_d] = run;                                                                                  \
  }                                                                                                                 \
  __syncthreads();                                                                                                  \
  const float g_off = g_half ? sHT[g_d] : 0.f;                                                                      \
  const float g_bend = sHT[g_d] + sHT[128 + g_d];

__device__ __forceinline__ void gla_phase_a(const Ctx& cx, const Params& p, int l, int job) {
  const u16* Y = (const u16*)(cx.ws + WS_Y);
  u16* GST = (u16*)(cx.ws + WS_GST);
  float* GDEC = (float*)(cx.ws + WS_GDEC);
  int seq, h, tok0, valid;
  gla_job_decode(job, seq, h, tok0, valid);
  __syncthreads();
  GLA_CUMSUM(l, h, tok0, valid)
  u16* sKd = (u16*)(smem + G_QD);
  {
    float run = g_off;
#pragma unroll 4
    for (int ii = 0; ii < 32; ++ii) {
      const int i = g_half * 32 + ii;
      run += GLA_LA(i, valid);
      float kv = 0.f;
      if (i < valid) kv = bf2f(Y[(long)(tok0 + i) * LDY + YK + h * 128 + g_d]);
      sKd[i * GS + g_d] = f2bf(kv * __expf(g_bend - run));
    }
  }
  if (g_half == 0) GDEC[job * 128 + g_d] = __expf(g_bend);
  __syncthreads();
  const int wid = g_tid >> 6, lane = g_tid & 63, fr = lane & 15, fq = lane >> 4;
  bf16x8 Af[4][2];
#pragma unroll
  for (int mt = 0; mt < 4; ++mt)
#pragma unroll
    for (int ks = 0; ks < 2; ++ks)
#pragma unroll
      for (int jj = 0; jj < 8; ++jj) {
        int jrow = ks * 32 + fq * 8 + jj;
        jrow = jrow < valid ? jrow : valid - 1;
        Af[mt][ks][jj] = (short)Y[(long)(tok0 + jrow) * LDY + YV + h * 256 + wid * 64 + mt * 16 + fr];
      }
#pragma unroll 1
  for (int nt = 0; nt < 8; ++nt) {
    bf16x8 Bf[2];
#pragma unroll
    for (int ks = 0; ks < 2; ++ks)
#pragma unroll
      for (int jj = 0; jj < 8; ++jj) Bf[ks][jj] = (short)sKd[(ks * 32 + fq * 8 + jj) * GS + nt * 16 + fr];
    f32x4 acc[4];
#pragma unroll
    for (int mt = 0; mt < 4; ++mt) {
      acc[mt] = (f32x4){0.f, 0.f, 0.f, 0.f};
#pragma unroll
      for (int ks = 0; ks < 2; ++ks) acc[mt] = __builtin_amdgcn_mfma_f32_16x16x32_bf16(Af[mt][ks], Bf[ks], acc[mt], 0, 0, 0);
    }
#pragma unroll
    for (int mt = 0; mt < 4; ++mt)
#pragma unroll
      for (int jj = 0; jj < 4; ++jj) {
        const int er = wid * 64 + mt * 16 + fq * 4 + jj;
        GST[(long)job * 32768 + er * 128 + nt * 16 + fr] = f2bf(acc[mt][jj]);
      }
  }
}

__device__ __forceinline__ void gla_phase_c(const Ctx& cx, const Params& p, int l, int job) {
  const u16* Y = (const u16*)(cx.ws + WS_Y);
  const u16* GST = (const u16*)(cx.ws + WS_GST);
  u16* OG = (u16*)(cx.ws + WS_OG);
  int seq, h, tok0, valid;
  gla_job_decode(job, seq, h, tok0, valid);
  __syncthreads();
  GLA_CUMSUM(l, h, tok0, valid)
  (void)g_bend;
  u16* sQd = (u16*)(smem + G_QD);
  u16* sKn = (u16*)(smem + G_KN);
  u16* sP = (u16*)(smem + G_P);
  float* sSS = (float*)(smem + G_SSS);
  {
    float run = g_off;
#pragma unroll 4
    for (int ii = 0; ii < 32; ++ii) {
      const int i = g_half * 32 + ii;
      run += GLA_LA(i, valid);
      float qv = 0.f, kv = 0.f;
      if (i < valid) {
        qv = bf2f(Y[(long)(tok0 + i) * LDY + YQ + h * 128 + g_d]);
        kv = bf2f(Y[(long)(tok0 + i) * LDY + YK + h * 128 + g_d]);
      }
      sQd[i * GS + g_d] = f2bf(qv * __expf(run) * 0.08838834764831845f);
      sKn[i * GS + g_d] = f2bf(kv * __expf(-run));
    }
  }
  __syncthreads();
  const int wid = g_tid >> 6, lane = g_tid & 63, fr = lane & 15, fq = lane >> 4;
  {
    f32x4 sc[4];
#pragma unroll
    for (int jt = 0; jt < 4; ++jt) sc[jt] = (f32x4){0.f, 0.f, 0.f, 0.f};
#pragma unroll
    for (int ks = 0; ks < 4; ++ks) {
      bf16x8 a = *(const bf16x8*)(sQd + (wid * 16 + fr) * GS + ks * 32 + fq * 8);
#pragma unroll
      for (int jt = 0; jt < 4; ++jt) {
        bf16x8 b = *(const bf16x8*)(sKn + (jt * 16 + fr) * GS + ks * 32 + fq * 8);
        sc[jt] = __builtin_amdgcn_mfma_f32_16x16x32_bf16(a, b, sc[jt], 0, 0, 0);
      }
    }
#pragma unroll
    for (int jt = 0; jt < 4; ++jt)
#pragma unroll
      for (int jj = 0; jj < 4; ++jj) {
        const int i = wid * 16 + fq * 4 + jj, j = jt * 16 + fr;
        sP[i * PS + j] = f2bf(j <= i ? sc[jt][jj] : 0.f);
      }
  }
  __syncthreads();
  f32x4 acc[4][4];
  acc_zero(acc);
#pragma unroll 1
  for (int ks = 0; ks < 4; ++ks) {
    bf16x8 a[4];
#pragma unroll
    for (int mt = 0; mt < 4; ++mt) a[mt] = *(const bf16x8*)(sQd + (mt * 16 + fr) * GS + ks * 32 + fq * 8);
#pragma unroll
    for (int nt = 0; nt < 4; ++nt) {
      const bf16x8 b = *(const bf16x8*)(GST + (long)job * 32768 + (wid * 64 + nt * 16 + fr) * 128 + ks * 32 + fq * 8);
#pragma unroll
      for (int mt = 0; mt < 4; ++mt) acc[mt][nt] = __builtin_amdgcn_mfma_f32_16x16x32_bf16(a[mt], b, acc[mt][nt], 0, 0, 0);
    }
  }
#pragma unroll 1
  for (int ks = 0; ks < 2; ++ks) {
    bf16x8 a[4];
#pragma unroll
    for (int mt = 0; mt < 4; ++mt) a[mt] = *(const bf16x8*)(sP + (mt * 16 + fr) * PS + ks * 32 + fq * 8);
#pragma unroll
    for (int nt = 0; nt < 4; ++nt) {
      bf16x8 b;
#pragma unroll
      for (int jj = 0; jj < 8; ++jj) {
        int jrow = ks * 32 + fq * 8 + jj;
        jrow = jrow < valid ? jrow : valid - 1;
        b[jj] = (short)Y[(long)(tok0 + jrow) * LDY + YV + h * 256 + wid * 64 + nt * 16 + fr];
      }
#pragma unroll
      for (int mt = 0; mt < 4; ++mt) acc[mt][nt] = __builtin_amdgcn_mfma_f32_16x16x32_bf16(a[mt], b, acc[mt][nt], 0, 0, 0);
    }
  }
#pragma unroll
  for (int mt = 0; mt < 4; ++mt)
#pragma unroll
    for (int jj = 0; jj < 4; ++jj) {
      float s = 0.f;
#pragma unroll
      for (int nt = 0; nt < 4; ++nt) s += acc[mt][nt][jj] * acc[mt][nt][jj];
      s = row16_allsum(s);
      if (fr == 0) sSS[wid * 64 + mt * 16 + fq * 4 + jj] = s;
    }
  __syncthreads();
  const float* ng = p.in[11] + l * 1024 + h * 256;
#pragma unroll
  for (int mt = 0; mt < 4; ++mt)
#pragma unroll
    for (int jj = 0; jj < 4; ++jj) {
      const int i = mt * 16 + fq * 4 + jj;
      const float tot = sSS[i] + sSS[64 + i] + sSS[128 + i] + sSS[192 + i];
      const float rs = rsqrtf(tot * (1.f / 256.f) + 1e-6f);
      if (i < valid) {
#pragma unroll
        for (int nt = 0; nt < 4; ++nt) {
          const int e = wid * 64 + nt * 16 + fr;
          OG[(long)(tok0 + i) * 1024 + h * 256 + e] = f2bf(acc[mt][nt][jj] * rs * ng[e]);
        }
      }
    }
}

__device__ __forceinline__ void phase_mix1(const Ctx& cx, const Params& p, int l) {
  const int nj_gla = NGJOB, nj_lru = NMT * 8, nj_rw = NMT * 16;
  for (int job = BID; job < nj_gla + nj_lru + nj_rw; job += NBLK) {
    if (job < nj_gla) {
      gla_phase_a(cx, p, l, job);
    } else if (job < nj_gla + nj_lru) {
      const int jb = job - nj_gla, mt = jb >> 3, nb = jb & 7;
      const u16* XC = (const u16*)(cx.ws + WS_XC);
      const u16* WTL = (const u16*)(cx.ws + WS_WTLRU);
      u16* LLA = (u16*)(cx.ws + WS_LLA);
      u16* LVV = (u16*)(cx.ws + WS_LVV);
      const float* CSP = (const float*)(cx.ws + WS_CSP) + l * 1024;
      __syncthreads();
      {
        f32x4 acc[4][4];
        acc_zero(acc);
        gemm_mainloop(cx, acc, XC + (long)mt * 128 * 1024 + nb * 128, 1024, WTL + (long)((l * 2 + 0) * 8 + nb) * 16384, 128, 128);
        EPI4_BEGIN
          const int row = mt * 128 + lrow, col = nb * 128 + lcol;
          const float4 ba = *(const float4*)(p.in[15] + l * 1024 + col);
          const float4 sp = *(const float4*)(CSP + col);
          *(ushort4*)(LLA + (long)row * 1024 + col) = pack4(sigmoidf_(v[0] + ba.x) * sp.x, sigmoidf_(v[1] + ba.y) * sp.y,
                                                            sigmoidf_(v[2] + ba.z) * sp.z, sigmoidf_(v[3] + ba.w) * sp.w);
        EPI4_END
      }
      {
        f32x4 acc[4][4];
        acc_zero(acc);
        gemm_mainloop(cx, acc, XC + (long)mt * 128 * 1024 + nb * 128, 1024, WTL + (long)((l * 2 + 1) * 8 + nb) * 16384, 128, 128);
        EPI4_BEGIN
          const int row = mt * 128 + lrow, col = nb * 128 + lcol;
          const float4 bx = *(const float4*)(p.in[17] + l * 1024 + col);
          const ushort4 xc = *(const ushort4*)(XC + (long)row * 1024 + col);
          *(ushort4*)(LVV + (long)row * 1024 + col) = pack4(sigmoidf_(v[0] + bx.x) * bf2f(xc.x), sigmoidf_(v[1] + bx.y) * bf2f(xc.y),
                                                            sigmoidf_(v[2] + bx.z) * bf2f(xc.z), sigmoidf_(v[3] + bx.w) * bf2f(xc.w));
        EPI4_END
      }
    } else {
      const int jb = job - nj_gla - nj_lru, mt = jb >> 4, nt = (jb >> 1) & 7, which = jb & 1;
      const u16* RT = (const u16*)(cx.ws + WS_RT);
      const u16* WTR = (const u16*)(cx.ws + WS_WTRW);
      f32x4 acc[4][4];
      acc_zero(acc);
      __syncthreads();
      gemm_mainloop(cx, acc, RT + (long)mt * 128 * 128 + which * 64, 128, WTR + (long)(l * 2 + which) * 65536 + (long)nt * 128 * 64, 64, 64);
      if (which == 0) {
        float* RWW = (float*)(cx.ws + WS_RWW);
        EPI4_BEGIN
          const int row = mt * 128 + lrow, col = nt * 128 + lcol;
          const float4 w0 = *(const float4*)(p.in[20] + l * 1024 + col);
          float4 o;
          o.x = __expf(-sigmoidf_(w0.x + v[0]) * 0.6065306597126334f);
          o.y = __expf(-sigmoidf_(w0.y + v[1]) * 0.6065306597126334f);
          o.z = __expf(-sigmoidf_(w0.z + v[2]) * 0.6065306597126334f);
          o.w = __expf(-sigmoidf_(w0.w + v[3]) * 0.6065306597126334f);
          *(float4*)(RWW + (long)row * 1024 + col) = o;
        EPI4_END
      } else {
        u16* RWA = (u16*)(cx.ws + WS_RWA);
        EPI4_BEGIN
          const int row = mt * 128 + lrow, col = nt * 128 + lcol;
          const float4 a0 = *(const float4*)(p.in[22] + l * 1024 + col);
          *(ushort4*)(RWA + (long)row * 1024 + col) = pack4(sigmoidf_(a0.x + v[0]), sigmoidf_(a0.y + v[1]), sigmoidf_(a0.z + v[2]), sigmoidf_(a0.w + v[3]));
        EPI4_END
      }
    }
  }
}

__device__ __forceinline__ void lru_step4(const ushort4 la4, const ushort4 vv4, float (&h)[4], float (&A)[4], bool trackA) {
  const float la[4] = {bf2f(la4.x), bf2f(la4.y), bf2f(la4.z), bf2f(la4.w)};
  const float vv[4] = {bf2f(vv4.x), bf2f(vv4.y), bf2f(vv4.z), bf2f(vv4.w)};
#pragma unroll
  for (int j = 0; j < 4; ++j) {
    const float a = __expf(la[j]);
    const float u = sqrtf(fmaxf(1.f - a * a, 0.f)) * vv[j];
    if (trackA) A[j] *= a;
    h[j] = a * h[j] + u;
  }
}
__device__ __forceinline__ void phase_mix2(const Ctx& cx, const Params& p, int l, bool shadow = false) {
  u16* GST = (u16*)(cx.ws + WS_GST);
  const float* GDEC = (const float*)(cx.ws + WS_GDEC);
  const int gtid = BID * 256 + TID, gstr = NBLK * 256;
  for (int it = gtid; it < 48 * 4096; it += gstr) {
    const int sh = it >> 12, idx = (it & 4095) * 8, d = idx & 127, e = idx >> 7;
    float S[8];
    int job0, nch, jstride;
    float* outp;
    if (sh < 16) {
      const int seq = sh >> 2, h = sh & 3;
#pragma unroll
      for (int j = 0; j < 8; ++j) S[j] = 0.f;
      job0 = seq * 256 + h; nch = 64; jstride = 4;
      outp = cx.out + O_GLAP + ((long)((l * 4 + seq) * 4 + h)) * 32768 + d * 256 + e;
    } else {
      const int j_ = sh - 16, b = j_ >> 2, h = j_ & 3;
      const long so = ((long)((l * 8 + b) * 4 + h)) * 32768 + d * 256 + e;
#pragma unroll
      for (int j = 0; j < 8; ++j) S[j] = p.in[2][so + j * 256];
      job0 = 1024 + j_; nch = 1; jstride = 0;
      outp = cx.out + O_GLAS + so;
    }
    for (int ch0 = 0; ch0 < nch; ch0 += 8) {
      bf16x8 u[8];
      float4 da[8], db[8];
#pragma unroll
      for (int q = 0; q < 8; ++q) {
        if (ch0 + q < nch) {
          const int job = job0 + (ch0 + q) * jstride;
          u[q] = *(const bf16x8*)(GST + (long)job * 32768 + idx);
          da[q] = *(const float4*)(GDEC + job * 128 + d);
          db[q] = *(const float4*)(GDEC + job * 128 + d + 4);
        }
      }
#pragma unroll
      for (int q = 0; q < 8; ++q) {
        if (ch0 + q < nch) {
          const int job = job0 + (ch0 + q) * jstride;
          const float dd[8] = {da[q].x, da[q].y, da[q].z, da[q].w, db[q].x, db[q].y, db[q].z, db[q].w};
          bf16x8 o;
#pragma unroll
          for (int j = 0; j < 8; ++j) {
            o[j] = (short)f2bf(S[j]);
            S[j] = S[j] * dd[j] + bf2f((u16)u[q][j]);
          }
          if (!shadow) *(bf16x8*)(GST + (long)job * 32768 + idx) = o;
        }
      }
    }
#pragma unroll
    for (int j = 0; j < 8; ++j) outp[j * 256] = S[j];
  }
  const u16* LLA = (const u16*)(cx.ws + WS_LLA);
  const u16* LVV = (const u16*)(cx.ws + WS_LVV);
  float* LCH = (float*)(cx.ws + WS_LCH);
  for (int it = gtid; it < 4 * 64 * 256; it += gstr) {
    const int c = (it & 255) * 4, ch = (it >> 8) & 63, seq = it >> 14;
    const long t0 = (long)seq * 4096 + ch * 64;
    float A[4] = {1.f, 1.f, 1.f, 1.f}, H[4] = {0.f, 0.f, 0.f, 0.f};
#pragma unroll 16
    for (int t = 0; t < 64; ++t) {
      const ushort4 la4 = *(const ushort4*)(LLA + (t0 + t) * 1024 + c);
      const ushort4 vv4 = *(const ushort4*)(LVV + (t0 + t) * 1024 + c);
      lru_step4(la4, vv4, H, A, true);
    }
    *(float4*)(LCH + (long)(seq * 64 + ch) * 2048 + c) = make_float4(A[0], A[1], A[2], A[3]);
    *(float4*)(LCH + (long)(seq * 64 + ch) * 2048 + 1024 + c) = make_float4(H[0], H[1], H[2], H[3]);
  }
}

__device__ __forceinline__ void phase_mix3(const Ctx& cx, const Params& p, int l) {
  const int nblk_lru = (4 * 64 * 256 + 8 * 256) / 256;
  for (int job = BID; job < NGJOB + nblk_lru; job += NBLK) {
    if (job < NGJOB) {
      gla_phase_c(cx, p, l, job);
    } else {
      const int it = (job - NGJOB) * 256 + TID;
      const u16* __restrict__ LLA = (const u16*)(cx.ws + WS_LLA);
      const u16* __restrict__ LVV = (const u16*)(cx.ws + WS_LVV);
      const float* __restrict__ LCH = (const float*)(cx.ws + WS_LCH);
      u16* __restrict__ OL = (u16*)(cx.ws + WS_OL);
      int c, nt;
      long t0;
      float h[4] = {0.f, 0.f, 0.f, 0.f}, dummy[4];
      float* hout = nullptr;
      if (it < 4 * 64 * 256) {
        c = (it & 255) * 4;
        const int ch = (it >> 8) & 63, seq = it >> 14;
        t0 = (long)seq * 4096 + ch * 64;
        nt = 64;
#pragma unroll 8
        for (int q = 0; q < ch; ++q) {
          const float4 Aq = *(const float4*)(LCH + (long)(seq * 64 + q) * 2048 + c);
          const float4 Hq = *(const float4*)(LCH + (long)(seq * 64 + q) * 2048 + 1024 + c);
          h[0] = Aq.x * h[0] + Hq.x; h[1] = Aq.y * h[1] + Hq.y; h[2] = Aq.z * h[2] + Hq.z; h[3] = Aq.w * h[3] + Hq.w;
        }
        if (ch == 63) hout = cx.out + O_LHP + (long)(l * 4 + seq) * 1024 + c;
      } else {
        const int r = it - 4 * 64 * 256;
        c = (r & 255) * 4;
        const int b = r >> 8;
        t0 = NPT + b * 32;
        nt = 32;
        const float4 h0 = *(const float4*)(p.in[3] + (long)(l * 8 + b) * 1024 + c);
        h[0] = h0.x; h[1] = h0.y; h[2] = h0.z; h[3] = h0.w;
        hout = cx.out + O_LHS + (long)(l * 8 + b) * 1024 + c;
      }
#pragma unroll 8
      for (int t = 0; t < nt; ++t) {
        const ushort4 la4 = *(const ushort4*)(LLA + (t0 + t) * 1024 + c);
        const ushort4 vv4 = *(const ushort4*)(LVV + (t0 + t) * 1024 + c);
        lru_step4(la4, vv4, h, dummy, false);
        *(ushort4*)(OL + (t0 + t) * 1024 + c) = pack4(h[0], h[1], h[2], h[3]);
      }
      if (hout) *(float4*)hout = make_float4(h[0], h[1], h[2], h[3]);
    }
  }
}

__device__ __forceinline__ float row8_allsum(float x) {
  DPP_ADD(x, 0xB1);
  DPP_ADD(x, 0x4E);
  DPP_ADD(x, 0x141);
  return x;
}
__device__ __forceinline__ void bf8_to_f(const bf16x8 v, float (&o)[8]) {
#pragma unroll
  for (int j = 0; j < 8; ++j) o[j] = bf2f((u16)v[j]);
}
__device__ __forceinline__ void phase_rwprep(const Ctx& cx, const Params& p, int l, bool shadow = false) {
  const u16* __restrict__ Y = (const u16*)(cx.ws + WS_Y);
  u16* __restrict__ BR = (u16*)(cx.ws + WS_XC);
  u16* __restrict__ BK = (u16*)(cx.ws + WS_LVV);
  u16* __restrict__ BKK = (u16*)(cx.ws + WS_GST);
  u16* __restrict__ BKA = BKK + (long)NTOK * 1024;
  const u16* __restrict__ BA = (const u16*)(cx.ws + WS_RWA);
  u16* __restrict__ BV = (u16*)(cx.ws + WS_RWA);
  u16* __restrict__ REX = (u16*)(cx.ws + WS_LLA);
  const int ts = TID >> 7, c = (TID & 127) * 8;
  float mur[8], muk[8], muv[8], kkc[8], kac[8], rkc[8];
#pragma unroll
  for (int j = 0; j < 8; ++j) {
    mur[j] = p.in[19][l * 3200 + c + j];
    muk[j] = p.in[19][l * 3200 + 1024 + c + j];
    muv[j] = p.in[19][l * 3200 + 2048 + c + j];
    kkc[j] = p.in[24][l * 1024 + c + j];
    kac[j] = p.in[25][l * 1024 + c + j];
    rkc[j] = p.in[26][l * 1024 + c + j];
  }
#pragma unroll 2
  for (int tb = BID * 2; tb < NTOK; tb += NBLK * 2) {
    const int tok = tb + ts;
    int seq, pos, L;
    tok_decode(tok, seq, pos, L);
    const u16* yr = Y + (long)tok * LDY + YRW + c;
    float cr[8], ck[8], cv[8], af[8], pr[8], pk[8], pv[8];
    bf8_to_f(*(const bf16x8*)(yr), cr);
    bf8_to_f(*(const bf16x8*)(yr + 1024), ck);
    bf8_to_f(*(const bf16x8*)(yr + 2048), cv);
    bf8_to_f(*(const bf16x8*)(BA + (long)tok * 1024 + c), af);
    if (pos > 0) {
      bf8_to_f(*(const bf16x8*)(yr - LDY), pr);
      bf8_to_f(*(const bf16x8*)(yr - LDY + 1024), pk);
      bf8_to_f(*(const bf16x8*)(yr - LDY + 2048), pv);
    } else if (seq >= 4) {
      const float* s0 = p.in[6] + (long)(l * 8 + (seq - 4)) * 3200 + c;
#pragma unroll
      for (int j = 0; j < 8; ++j) { pr[j] = s0[j]; pk[j] = s0[1024 + j]; pv[j] = s0[2048 + j]; }
    } else {
#pragma unroll
      for (int j = 0; j < 8; ++j) { pr[j] = 0.f; pk[j] = 0.f; pv[j] = 0.f; }
    }
    float r[8], kp[8], v[8], kkr[8];
    float n2 = 0.f, rk = 0.f;
#pragma unroll
    for (int j = 0; j < 8; ++j) {
      r[j] = cr[j] + (pr[j] - cr[j]) * mur[j];
      const float k = ck[j] + (pk[j] - ck[j]) * muk[j];
      v[j] = cv[j] + (pv[j] - cv[j]) * muv[j];
      kkr[j] = k * kkc[j];
      n2 += kkr[j] * kkr[j];
      kp[j] = k * (1.f + (af[j] - 1.f) * kac[j]);
      rk += r[j] * kp[j] * rkc[j];
    }
    n2 = row8_allsum(n2);
    rk = row8_allsum(rk);
    const float rn = rsqrtf(n2 + 1e-12f);
    bf16x8 o_r, o_k, o_kk, o_ka, o_v, o_e;
#pragma unroll
    for (int j = 0; j < 8; ++j) {
      o_r[j] = (short)f2bf(r[j]);
      o_k[j] = (short)f2bf(kp[j]);
      o_kk[j] = (short)f2bf(kkr[j] * rn);
      o_ka[j] = (short)f2bf(kkr[j] * rn * af[j]);
      o_v[j] = (short)f2bf(v[j]);
      o_e[j] = (short)f2bf(rk * v[j]);
    }
    const long o = (long)tok * 1024 + c;
    *(bf16x8*)(BR + o) = o_r;
    *(bf16x8*)(BK + o) = o_k;
    *(bf16x8*)(BKK + o) = o_kk;
    *(bf16x8*)(BKA + o) = o_ka;
    if (!shadow) *(bf16x8*)(BV + o) = o_v;
    *(bf16x8*)(REX + o) = o_e;
  }
}

__device__ __forceinline__ void inproj2_tile(const Ctx& cx, int mt, int nt, const float* gnw, const float* gnb);
constexpr int RT_T = 16;
typedef float f32x2 __attribute__((ext_vector_type(2)));
__device__ __forceinline__ void phase_rwscan(const Ctx& cx, const Params& p, int l, int l2) {
  const u16* BR = (const u16*)(cx.ws + WS_XC);
  const u16* BK = (const u16*)(cx.ws + WS_LVV);
  const u16* BKK = (const u16*)(cx.ws + WS_GST);
  const u16* BKA = BKK + (long)NTOK * 1024;
  const u16* BV = (const u16*)(cx.ws + WS_RWA);
  const float* RWW = (const float*)(cx.ws + WS_RWW);
  u16* OR = (u16*)(cx.ws + WS_OR);
  float* sR = (float*)smem;
  float* sW = sR + RT_T * 64;
  float* sK = sW + RT_T * 64;
  float* sKK = sK + RT_T * 64;
  float* sKA = sKK + RT_T * 64;
  float* sV = sKA + RT_T * 64;
  float* sY = sV + RT_T * 64;
  const int tid = TID, wave = tid >> 6, lane = tid & 63;
  int* ctl = (int*)(cx.ws + WS_CTL);
  volatile int* s_ctl = (volatile int*)(smem + SMEM_CTL);
  if (tid == 0) {
    const unsigned xcc = (unsigned)__builtin_amdgcn_s_getreg((3 << 11) | 20) & 0xFu;
    const unsigned cu = ((unsigned)__builtin_amdgcn_s_getreg(63492) >> 8) & 0xFFu;
    const int key = l2 * 4096 + xcc * 256 + cu;
    int role;
    if (atomicAdd(ctl + CTL_CLAIM + key, 1) == 0) {
      const int rank = atomicAdd(ctl + CTL_NCU + l2, 1);
      role = (rank < 128) ? 2 : 1;
      __hip_atomic_store(ctl + CTL_ROLE + key, role, __ATOMIC_RELAXED, __HIP_MEMORY_SCOPE_AGENT);
    } else {
      int spins = 0;
      while ((role = __hip_atomic_load(ctl + CTL_ROLE + key, __ATOMIC_RELAXED, __HIP_MEMORY_SCOPE_AGENT)) == 0 && ++spins < (1 << 20)) __builtin_amdgcn_s_sleep(1);
      if (role == 0) role = 1;
    }
    s_ctl[1] = (role == 2) ? 1 : 0;
  }
  __syncthreads();
  const int first = s_ctl[1];
  int stage = first ? 0 : 1;
  for (;;) {
    __syncthreads();
    if (tid == 0) {
      int job = -1, st = stage;
      while (job < 0 && st < 4) {
        if (st == 0 || st == 3) {
          const int j = atomicAdd(ctl + CTL_QP + l2, 1);
          if (j < 256) job = j; else ++st;
        } else if (st == 1) {
          const int j = atomicAdd(ctl + CTL_QS + l2, 1);
          if (j < 512) job = 256 + j; else ++st;
        } else {
          const int total = NMT * 40;
          for (int a = 0; a < 8 && job < 0; ++a) {
            const int x = (BID + a) & 7;
            const int c = atomicAdd(ctl + CTL_QG + l2 * 8 + x, 1);
            const int t = ((c >> 6) * 8 + x) * 64 + (c & 63);
            if (t < total) job = 1024 + t;
          }
          if (job < 0) ++st;
        }
      }
      s_ctl[2] = job;
      s_ctl[3] = st;
    }
    __syncthreads();
    const int job = s_ctl[2];
    stage = s_ctl[3];
    if (job < 0) break;
    if (stage == 0) stage = 1;
    if (job >= 1024) {
      const int t = job - 1024, sn = t / (NMT * 8), r = t % (NMT * 8);
      const int mt = r >> 3, ni = sn * 8 + (r & 7);
      inproj2_tile(cx, mt, ni < 16 ? ni : ni + 8, nullptr, nullptr);
      continue;
    }
    int seq, h, rq, L, t0;
    if (job < 256) { seq = job >> 6; h = (job >> 2) & 15; rq = job & 3; L = 4096; t0 = seq * 4096; }
    else { int j = job - 256; seq = 4 + (j >> 6); h = (j >> 2) & 15; rq = j & 3; L = 32; t0 = NPT + (seq - 4) * 32; }
    const int rloc = wave * 4 + (lane >> 4), row = rq * 16 + rloc, kq = lane & 15;
    float S0, S1, S2, S3;
    if (seq >= 4) {
      const float4 s = *(const float4*)(p.in[5] + ((((long)(l * 8 + (seq - 4)) * 16 + h) * 64 + row) * 64 + kq * 4));
      S0 = s.x; S1 = s.y; S2 = s.z; S3 = s.w;
    } else { S0 = S1 = S2 = S3 = 0.f; }
    ushort4 gr0, gk0, gkk0, gka0, gv0, gr1, gk1, gkk1, gka1, gv1;
    float4 gw0, gw1;
    const int ntiles = L / RT_T;
    const int pf_tt = tid >> 4, pf_c4 = (tid & 15) * 4;
#define RW_LOAD(tile_, Q)                                                                      \
    {                                                                                          \
      const long o = (long)(t0 + (tile_) * RT_T + pf_tt) * 1024 + h * 64 + pf_c4;              \
      gr##Q = *(const ushort4*)(BR + o);                                                       \
      gk##Q = *(const ushort4*)(BK + o);                                                       \
      gkk##Q = *(const ushort4*)(BKK + o);                                                     \
      gka##Q = *(const ushort4*)(BKA + o);                                                     \
      gv##Q = *(const ushort4*)(BV + o);                                                       \
      gw##Q = *(const float4*)(RWW + o);                                                       \
    }
#define RW_STORE(Q)                                                                                              \
    {                                                                                                            \
      const int o = pf_tt * 64 + pf_c4;                                                                          \
      *(float4*)(sR + o) = make_float4(bf2f(gr##Q.x), bf2f(gr##Q.y), bf2f(gr##Q.z), bf2f(gr##Q.w));              \
      *(float4*)(sK + o) = make_float4(bf2f(gk##Q.x), bf2f(gk##Q.y), bf2f(gk##Q.z), bf2f(gk##Q.w));              \
      *(float4*)(sKK + o) = make_float4(bf2f(gkk##Q.x), bf2f(gkk##Q.y), bf2f(gkk##Q.z), bf2f(gkk##Q.w));         \
      *(float4*)(sKA + o) = make_float4(bf2f(gka##Q.x), bf2f(gka##Q.y), bf2f(gka##Q.z), bf2f(gka##Q.w));         \
      *(float4*)(sV + o) = make_float4(bf2f(gv##Q.x), bf2f(gv##Q.y), bf2f(gv##Q.z), bf2f(gv##Q.w));              \
      *(float4*)(sW + o) = gw##Q;                                                                                \
    }
#define RW_LD(tt_, X)                                                 \
      X##w = *(const float4*)(sW + (tt_) * 64 + kq * 4);               \
      X##k = *(const float4*)(sK + (tt_) * 64 + kq * 4);               \
      X##kk = *(const float4*)(sKK + (tt_) * 64 + kq * 4);             \
      X##ka = *(const float4*)(sKA + (tt_) * 64 + kq * 4);             \
      X##r = *(const float4*)(sR + (tt_) * 64 + kq * 4);               \
      X##v = sV[(tt_) * 64 + row];
#define LO2(v4) ((f32x2){(v4).x, (v4).y})
#define HI2(v4) ((f32x2){(v4).z, (v4).w})
#define RW_STEP(tt_, X)                                                                            \
      {                                                                                            \
        f32x2 d = S01 * LO2(X##kk);                                                                \
        d = __builtin_elementwise_fma(S23, HI2(X##kk), d);                                         \
        float sk = d.x + d.y;                                                                      \
        sk = row16_allsum(sk);                                                                     \
        const f32x2 vv2 = (f32x2){X##v, X##v}, nsk2 = (f32x2){-sk, -sk};                           \
        f32x2 t01 = LO2(X##k) * vv2, t23 = HI2(X##k) * vv2;                                        \
        t01 = __builtin_elementwise_fma(LO2(X##ka), nsk2, t01);                                    \
        t23 = __builtin_elementwise_fma(HI2(X##ka), nsk2, t23);                                    \
        S01 = __builtin_elementwise_fma(S01, LO2(X##w), t01);                                      \
        S23 = __builtin_elementwise_fma(S23, HI2(X##w), t23);                                      \
        f32x2 y2 = S01 * LO2(X##r);                                                                \
        y2 = __builtin_elementwise_fma(S23, HI2(X##r), y2);                                        \
        sY[(tt_) * 256 + wave * 64 + lane] = y2.x + y2.y;                                          \
      }                                                                                            \
      __builtin_amdgcn_sched_barrier(0);
#define RW_TILE(tile_, Q)                                                                          \
    {                                                                                              \
      RW_STORE(Q)                                                                                  \
      __syncthreads();                                                                             \
      if ((tile_) + 2 < ntiles) { RW_LOAD((tile_) + 2, Q) }                                        \
      float4 Aw, Ak, Akk, Aka, Ar, Bw, Bk, Bkk, Bka, Br;                                           \
      float Av, Bv;                                                                                \
      RW_LD(0, A)                                                                                  \
      _Pragma("unroll 2") for (int tt = 0; tt < RT_T; tt += 2) {                                   \
        RW_LD(tt + 1, B)                                                                           \
        __builtin_amdgcn_sched_barrier(0);                                                         \
        RW_STEP(tt, A)                                                                             \
        { const int tn = (tt + 2 < RT_T) ? tt + 2 : tt; RW_LD(tn, A) }                             \
        __builtin_amdgcn_sched_barrier(0);                                                         \
        RW_STEP(tt + 1, B)                                                                         \
      }                                                                                            \
      __syncthreads();                                                                             \
      {                                                                                            \
        const int tt = tid >> 4, rr = tid & 15;                                                    \
        const float4 y0 = *(const float4*)(sY + tt * 256 + rr * 16), y1 = *(const float4*)(sY + tt * 256 + rr * 16 + 4);      \
        const float4 y2 = *(const float4*)(sY + tt * 256 + rr * 16 + 8), y3 = *(const float4*)(sY + tt * 256 + rr * 16 + 12); \
        const float ys = ((y0.x + y0.y) + (y0.z + y0.w)) + ((y1.x + y1.y) + (y1.z + y1.w)) + ((y2.x + y2.y) + (y2.z + y2.w)) + ((y3.x + y3.y) + (y3.z + y3.w)); \
        OR[(long)(t0 + (tile_) * RT_T + tt) * 1024 + h * 64 + rq * 16 + rr] = f2bf(ys);             \
      }                                                                                            \
    }
    f32x2 S01, S23;
    S01.x = S0; S01.y = S1; S23.x = S2; S23.y = S3;
    RW_LOAD(0, 0)
    if (ntiles > 1) { RW_LOAD(1, 1) }
    for (int tile = 0; tile < ntiles; tile += 2) {
      RW_TILE(tile, 0)
      if (tile + 1 < ntiles) RW_TILE(tile + 1, 1)
    }
#undef RW_TILE
#undef RW_LD
#undef RW_STEP
#undef LO2
#undef HI2
#undef RW_STORE
#undef RW_LOAD
    const float S0o = S01.x, S1o = S01.y, S2o = S23.x, S3o = S23.y;
    float* so = (seq < 4) ? (cx.out + O_RWP + ((((long)(l * 4 + seq) * 16 + h) * 64 + row) * 64 + kq * 4))
                          : (cx.out + O_RWS + ((((long)(l * 8 + (seq - 4)) * 16 + h) * 64 + row) * 64 + kq * 4));
    *(float4*)so = make_float4(S0o, S1o, S2o, S3o);
    __syncthreads();
  }
}

__device__ __forceinline__ void phase_rwgn(const Ctx& cx, const Params& p, int l) {
  u16* __restrict__ OR = (u16*)(cx.ws + WS_OR);
  const u16* __restrict__ ORr = (const u16*)(cx.ws + WS_OR);
  const u16* __restrict__ REX = (const u16*)(cx.ws + WS_LLA);
  const int c = TID * 4;
  const float4 gw = *(const float4*)(p.in[27] + l * 1024 + c);
  const float4 gb = *(const float4*)(p.in[28] + l * 1024 + c);
#pragma unroll 4
  for (int tok = BID; tok < NTOK; tok += NBLK) {
    const ushort4 yv = *(const ushort4*)(ORr + (long)tok * 1024 + c);
    const ushort4 ev = *(const ushort4*)(REX + (long)tok * 1024 + c);
    const float y0 = bf2f(yv.x), y1 = bf2f(yv.y), y2 = bf2f(yv.z), y3 = bf2f(yv.w);
    float s = y0 + y1 + y2 + y3, ss = y0 * y0 + y1 * y1 + y2 * y2 + y3 * y3;
    s = row16_allsum(s);
    ss = row16_allsum(ss);
    const float mean = s * (1.f / 64.f);
    const float var = fmaxf(ss * (1.f / 64.f) - mean * mean, 0.f);
    const float rs = rsqrtf(var + 64e-5f);
    ushort4 o;
    o.x = f2bf((y0 - mean) * rs * gw.x + gb.x + bf2f(ev.x));
    o.y = f2bf((y1 - mean) * rs * gw.y + gb.y + bf2f(ev.y));
    o.z = f2bf((y2 - mean) * rs * gw.z + gb.z + bf2f(ev.z));
    o.w = f2bf((y3 - mean) * rs * gw.w + gb.w + bf2f(ev.w));
    *(ushort4*)(OR + (long)tok * 1024 + c) = o;
  }
}

__device__ __forceinline__ void inproj2_tile(const Ctx& cx, int mt, int nt, const float* gnw, const float* gnb) {
  const u16* XN = (const u16*)(cx.ws + WS_XN);
  const u16* WT = (const u16*)(cx.ws + WS_WTIN) + (long)6400 * 1024;
  u16* Y = (u16*)(cx.ws + WS_Y);
  f32x4 acc[4][4];
  acc_zero(acc);
  gemm_mainloop(cx, acc, XN + (long)mt * 128 * 1024, 1024, WT + (long)nt * 128 * 1024, 1024, 1024);
  const int grp = nt >> 3;
  if (grp == 2) {
    const u16* OR = (const u16*)(cx.ws + WS_OR);
    const u16* REX = (const u16*)(cx.ws + WS_LLA);
    int e_z = 0; asm volatile("" : "+v"(e_z));
    const int e_tid = TID + e_z, e_wid = e_tid >> 6, e_lane = e_tid & 63, e_wr = e_wid >> 1, e_wc = e_wid & 1, e_fr = e_lane & 15, e_fq = e_lane >> 4;
#pragma unroll
    for (int m = 0; m < 4; ++m) {
      __builtin_amdgcn_sched_barrier(0);
      const int row = mt * 128 + e_wr * 64 + m * 16 + e_fr;
      const int cb = (nt & 7) * 128 + e_wc * 64 + e_fq * 4;
      ushort4 yv[4];
      float s = 0.f, ss = 0.f;
#pragma unroll
      for (int n = 0; n < 4; ++n) {
        yv[n] = *(const ushort4*)(OR + (long)row * 1024 + cb + n * 16);
        const float y0 = bf2f(yv[n].x), y1 = bf2f(yv[n].y), y2 = bf2f(yv[n].z), y3 = bf2f(yv[n].w);
        s += (y0 + y1) + (y2 + y3);
        ss += (y0 * y0 + y1 * y1) + (y2 * y2 + y3 * y3);
      }
      s += __shfl_xor(s, 16); ss += __shfl_xor(ss, 16);
      s += __shfl_xor(s, 32); ss += __shfl_xor(ss, 32);
      const float mean = s * (1.f / 64.f);
      const float rs = rsqrtf(fmaxf(ss * (1.f / 64.f) - mean * mean, 0.f) + 64e-5f);
#pragma unroll
      for (int n = 0; n < 4; ++n) {
        const int col = cb + n * 16;
        const ushort4 ev = *(const ushort4*)(REX + (long)row * 1024 + col);
        const float4 gw = *(const float4*)(gnw + col), gb = *(const float4*)(gnb + col);
        const f32x4 v = acc[m][n];
        const float o0 = (bf2f(yv[n].x) - mean) * rs * gw.x + gb.x + bf2f(ev.x);
        const float o1 = (bf2f(yv[n].y) - mean) * rs * gw.y + gb.y + bf2f(ev.y);
        const float o2 = (bf2f(yv[n].z) - mean) * rs * gw.z + gb.z + bf2f(ev.z);
        const float o3 = (bf2f(yv[n].w) - mean) * rs * gw.w + gb.w + bf2f(ev.w);
        *(ushort4*)(Y + (long)row * LDY + nt * 128 + e_wc * 64 + n * 16 + e_fq * 4) = pack4(o0 * siluf_(v[0]), o1 * siluf_(v[1]), o2 * siluf_(v[2]), o3 * siluf_(v[3]));
      }
    }
  } else if (grp < 3) {
    const u16* O = (const u16*)(cx.ws + (grp == 0 ? WS_OG : WS_OL));
    EPI4_BEGIN
      const int row = mt * 128 + lrow, col = (nt & 7) * 128 + lcol;
      const ushort4 ov = *(const ushort4*)(O + (long)row * 1024 + col);
      *(ushort4*)(Y + (long)row * LDY + nt * 128 + lcol) = pack4(bf2f(ov.x) * siluf_(v[0]), bf2f(ov.y) * siluf_(v[1]), bf2f(ov.z) * siluf_(v[2]), bf2f(ov.w) * siluf_(v[3]));
    EPI4_END
  } else {
    EPI4_BEGIN
      const int row = mt * 128 + lrow;
      *(ushort4*)(Y + (long)row * LDY + nt * 128 + lcol) = pack4(sigmoidf_(v[0]), sigmoidf_(v[1]), sigmoidf_(v[2]), sigmoidf_(v[3]));
    EPI4_END
  }
}
__device__ __forceinline__ void inproj2_tile160_rw(const Ctx& cx, int mt, int nt, const float* gnw, const float* gnb) {
  const u16* XN = (const u16*)(cx.ws + WS_XN);
  const u16* WT = (const u16*)(cx.ws + WS_WTIN) + (long)6400 * 1024;
  u16* Y = (u16*)(cx.ws + WS_Y);
  f32x4 acc[5][4];
  acc_zero5(acc);
  gemm_mainloop3(cx, acc, XN + (long)mt * 160 * 1024, 1024, WT + (long)nt * 128 * 1024, 1024, 1024);
  const u16* OR = (const u16*)(cx.ws + WS_OR);
  const u16* REX = (const u16*)(cx.ws + WS_LLA);
  int e_z = 0; asm volatile("" : "+v"(e_z));
  const int e_tid = TID + e_z, e_wid = e_tid >> 6, e_lane = e_tid & 63, e_wr = e_wid >> 1, e_wc = e_wid & 1, e_fr = e_lane & 15, e_fq = e_lane >> 4;
#pragma unroll
  for (int m = 0; m < 5; ++m) {
    __builtin_amdgcn_sched_barrier(0);
    const int row = mt * 160 + e_wr * 80 + m * 16 + e_fr;
    const int cb = (nt & 7) * 128 + e_wc * 64 + e_fq * 4;
    ushort4 yv[4];
    float s_ = 0.f, ss = 0.f;
#pragma unroll
    for (int n = 0; n < 4; ++n) {
      yv[n] = *(const ushort4*)(OR + (long)row * 1024 + cb + n * 16);
      const float y0 = bf2f(yv[n].x), y1 = bf2f(yv[n].y), y2 = bf2f(yv[n].z), y3 = bf2f(yv[n].w);
      s_ += (y0 + y1) + (y2 + y3);
      ss += (y0 * y0 + y1 * y1) + (y2 * y2 + y3 * y3);
    }
    s_ += __shfl_xor(s_, 16); ss += __shfl_xor(ss, 16);
    s_ += __shfl_xor(s_, 32); ss += __shfl_xor(ss, 32);
    const float mean = s_ * (1.f / 64.f);
    const float rs = rsqrtf(fmaxf(ss * (1.f / 64.f) - mean * mean, 0.f) + 64e-5f);
#pragma unroll
    for (int n = 0; n < 4; ++n) {
      const int col = cb + n * 16;
      const ushort4 ev = *(const ushort4*)(REX + (long)row * 1024 + col);
      const float4 gw = *(const float4*)(gnw + col), gb = *(const float4*)(gnb + col);
      const f32x4 v = acc[m][n];
      const float o0 = (bf2f(yv[n].x) - mean) * rs * gw.x + gb.x + bf2f(ev.x);
      const float o1 = (bf2f(yv[n].y) - mean) * rs * gw.y + gb.y + bf2f(ev.y);
      const float o2 = (bf2f(yv[n].z) - mean) * rs * gw.z + gb.z + bf2f(ev.z);
      const float o3 = (bf2f(yv[n].w) - mean) * rs * gw.w + gb.w + bf2f(ev.w);
      *(ushort4*)(Y + (long)row * LDY + nt * 128 + e_wc * 64 + n * 16 + e_fq * 4) = pack4(o0 * siluf_(v[0]), o1 * siluf_(v[1]), o2 * siluf_(v[2]), o3 * siluf_(v[3]));
    }
  }
}
__device__ __forceinline__ void phase_inproj2(const Ctx& cx, const Params& p, int l) {
  TILE3_LOOP_BEGIN(8)
    inproj2_tile160_rw(cx, mt, nt + 16, p.in[27] + l * 1024, p.in[28] + l * 1024);
  TILE_LOOP_END
}

template <int B>
__device__ __forceinline__ void merge_step(const Ctx& cx, int l, int mt, int nt) {
  const u16* Y = (const u16*)(cx.ws + WS_Y);
  const u16* WTP = (const u16*)(cx.ws + WS_WTP);
  u16* MG = (u16*)(cx.ws + WS_XC);
  float* TF = (float*)(cx.ws + WS_RWW);
  f32x4 acc[5][4];
  acc_zero5(acc);
  gemm_mainloop3(cx, acc, Y + (long)mt * 160 * LDY + B * 1024, LDY, WTP + (long)(l * 4 + B) * 1048576 + (long)nt * 128 * 1024, 1024, 1024);
  EPI5_BEGIN
    const int row = mt * 160 + lrow, col = nt * 128 + lcol;
    const ushort4 g = *(const ushort4*)(Y + (long)row * LDY + 3072 + B * 1024 + col);
    float4 t = make_float4(bf2f(g.x) * v[0], bf2f(g.y) * v[1], bf2f(g.z) * v[2], bf2f(g.w) * v[3]);
    if (B > 0) {
      const float4 o = *(const float4*)(TF + (long)row * 1024 + col);
      t.x += o.x; t.y += o.y; t.z += o.z; t.w += o.w;
    }
    if (B < 2) *(float4*)(TF + (long)row * 1024 + col) = t;
    else *(ushort4*)(MG + (long)row * 1024 + col) = pack4(t.x, t.y, t.z, t.w);
  EPI5_END
}
__device__ __forceinline__ void phase_merge(const Ctx& cx, const Params& p, int l) {
  TILE3_LOOP_BEGIN(8)
    merge_step<0>(cx, l, mt, nt);
    merge_step<1>(cx, l, mt, nt);
    merge_step<2>(cx, l, mt, nt);
  TILE_LOOP_END
}

__device__ __forceinline__ void phase_out(const Ctx& cx, const Params& p, int l) {
  const u16* MG = (const u16*)(cx.ws + WS_XC);
  const u16* WTP = (const u16*)(cx.ws + WS_WTP);
  float* X = (float*)(cx.ws + WS_X);
  TILE3_LOOP_BEGIN(8)
    f32x4 acc[5][4];
    acc_zero5(acc);
    gemm_mainloop3(cx, acc, MG + (long)mt * 160 * 1024, 1024, WTP + (long)(l * 4 + 3) * 1048576 + (long)nt * 128 * 1024, 1024, 1024);
    EPI5_BEGIN
      const int row = mt * 160 + lrow, col = nt * 128 + lcol;
      float4 x = *(const float4*)(X + (long)row * 1024 + col);
      x.x += v[0]; x.y += v[1]; x.z += v[2]; x.w += v[3];
      *(float4*)(X + (long)row * 1024 + col) = x;
    EPI5_END
  TILE_LOOP_END
}


#define HB_CNT(x)  (64 * (x))
#define HB_GEN(x)  (64 * (16 + (x)))
#define HB_CEN(x)  (64 * (32 + (x)))
#define HB_TOP     (64 * 48)
__device__ __forceinline__ unsigned hb_ld(unsigned* p) { return __hip_atomic_load(p, __ATOMIC_RELAXED, __HIP_MEMORY_SCOPE_AGENT); }
__device__ __forceinline__ unsigned hb_xcc() { return (unsigned)__builtin_amdgcn_s_getreg((3 << 11) | 20) & 0xFu; }
__device__ __forceinline__ void hier_barrier(unsigned* bar, unsigned k, volatile unsigned* st) {
  asm volatile("s_waitcnt vmcnt(0)" ::: "memory");
  __syncthreads();
  if (threadIdx.x == 0) {
    const unsigned x = hb_xcc();
    unsigned per = st[0], nx = st[1];
    if (per == 0u) {
      const unsigned G = gridDim.x;
      for (;;) {
        unsigned sum = 0u, cnt = 0u, mine = 0u;
#pragma unroll
        for (unsigned j = 0; j < 16; ++j) { const unsigned c = hb_ld(&bar[HB_CEN(j)]); sum += c; cnt += (c > 0u) ? 1u : 0u; mine = (j == x) ? c : mine; }
        if (sum == G) { per = mine; nx = cnt; break; }
        __builtin_amdgcn_s_sleep(1);
      }
      st[0] = per; st[1] = nx;
    }
    const unsigned old = __hip_atomic_fetch_add(&bar[HB_CNT(x)], 1u, __ATOMIC_RELAXED, __HIP_MEMORY_SCOPE_AGENT);
    if (old + 1u == per * k) {
      __builtin_amdgcn_fence(__ATOMIC_RELEASE, "agent");
      asm volatile("s_waitcnt vmcnt(0)" ::: "memory");
      const unsigned ot = __hip_atomic_fetch_add(&bar[HB_TOP], 1u, __ATOMIC_RELAXED, __HIP_MEMORY_SCOPE_AGENT);
      if (ot + 1u == nx * k) {
#pragma unroll
        for (unsigned j = 0; j < 16; ++j) __hip_atomic_store(&bar[HB_GEN(j)], k, __ATOMIC_RELAXED, __HIP_MEMORY_SCOPE_AGENT);
      }
    }
    while (hb_ld(&bar[HB_GEN(x)]) < k) __builtin_amdgcn_s_sleep(1);
    __builtin_amdgcn_fence(__ATOMIC_ACQUIRE, "agent");
    asm volatile("s_waitcnt vmcnt(0)" ::: "memory");
  }
  __syncthreads();
}

constexpr int PH_PER_LAYER = 11;
constexpr int N_PHASES = 1 + 4 * PH_PER_LAYER + 1;

__global__ void __launch_bounds__(256, 2) fwd_kernel(Params p) {
  cg::grid_group grid = cg::this_grid();
  volatile unsigned* hb_st = (volatile unsigned*)(smem + SMEM_CTL + 32);
  if (threadIdx.x == 0) { hb_st[0] = 0u; hb_st[1] = 0u; }
  __syncthreads();
  unsigned hb_k = 0u;
#pragma unroll 1
  for (int ph = p.ph0; ph < p.ph1; ++ph) {
    int zv = 0, zs = 0;
    asm volatile("" : "+v"(zv));
    asm volatile("" : "+s"(zs));
    Ctx cx;
    cx.tid = threadIdx.x + zv;
    cx.bid = blockIdx.x + zs;
    cx.nb = gridDim.x + zs;
    cx.ws = p.ws + zs;
    cx.out = p.out + zs;
    if (ph == 0) phase_convw(cx, p);
    else if (ph == N_PHASES - 1) phase_norm(cx, p, 4);
    else {
      const int l = (ph - 1) / PH_PER_LAYER, s = (ph - 1) % PH_PER_LAYER;
      switch (s) {
        case 0: phase_norm(cx, p, l); break;
        case 1: phase_inproj1(cx, p); if (PROBE_DUP & 1) { grid.sync(); phase_inproj1(cx, p); } break;
        case 2: phase_prep(cx, p, l); if (PROBE_DUP & 16) { grid.sync(); phase_prep(cx, p, l); } break;
        case 3: phase_mix1(cx, p, l); if (PROBE_DUP & 4) { grid.sync(); phase_mix1(cx, p, l); } break;
        case 4: if (PROBE_DUP & 64) { phase_mix2(cx, p, l, true); grid.sync(); } phase_mix2(cx, p, l); break;
        case 5: phase_mix3(cx, p, l); if (PROBE_DUP & 4) { grid.sync(); phase_mix3(cx, p, l); } break;
        case 6: if (PROBE_DUP & 128) { phase_rwprep(cx, p, l, true); grid.sync(); } phase_rwprep(cx, p, l); break;
        case 7: phase_rwscan(cx, p, l, l * 2); if (PROBE_DUP & 2) { grid.sync(); phase_rwscan(cx, p, l, l * 2 + 1); } break;
        case 8: phase_inproj2(cx, p, l); break;
        case 9: phase_merge(cx, p, l); break;
        default: phase_out(cx, p, l); break;
      }
    }
    if (ph + 1 < p.ph1) {
      if (ph == p.ph0) {
        grid.sync();
        if (threadIdx.x == 0) (void)__hip_atomic_fetch_add((unsigned*)(p.ws + WS_BAR) + HB_CEN(hb_xcc()), 1u, __ATOMIC_RELAXED, __HIP_MEMORY_SCOPE_AGENT);
      } else hier_barrier((unsigned*)(p.ws + WS_BAR), ++hb_k, hb_st);
    }
  }
}

extern "C" void kernel_launch(void* const* d_in, const int* in_sizes, int n_in, void* d_out, int out_size, void* d_ws, size_t ws_size,
                              hipStream_t stream) {
  static int grid_blocks = 0;
  if (!grid_blocks) {
    int dev = 0, cus = 0, per_cu = 0;
    hipGetDevice(&dev);
    hipDeviceGetAttribute(&cus, hipDeviceAttributeMultiprocessorCount, dev);
    (void)hipFuncSetAttribute((const void*)fwd_kernel, hipFuncAttributeMaxDynamicSharedMemorySize, SMEM_BYTES);
    hipOccupancyMaxActiveBlocksPerMultiprocessor(&per_cu, (const void*)fwd_kernel, 256, SMEM_BYTES);
    if (per_cu < 1) per_cu = 1;
    if (per_cu > 2) per_cu = 2;
    grid_blocks = cus * per_cu;
    if (ws_size < WS_END) fprintf(stderr, "workspace too small: %zu < %zu\n", ws_size, (size_t)WS_END);
  }
  if (n_in < 34 || ws_size < WS_END) return;
  Params p{};
  for (int i = 0; i < 34; ++i) p.in[i] = (const float*)d_in[i];
  p.out = (float*)d_out;
  p.ws = (unsigned char*)d_ws;
#if MULTI_LAUNCH
  for (int ph = 0; ph < N_PHASES; ++ph) {
    p.ph0 = ph; p.ph1 = ph + 1;
    hipLaunchKernelGGL(fwd_kernel, dim3(grid_blocks), dim3(256), SMEM_BYTES, stream, p);
  }
#else
  p.ph0 = 0; p.ph1 = N_PHASES;
  void* args[] = {&p};
  hipError_t e = hipLaunchCooperativeKernel((const void*)fwd_kernel, dim3(grid_blocks), dim3(256), args, SMEM_BYTES, stream);
  if (e != hipSuccess) fprintf(stderr, "cooperative launch failed: %s (grid %d)\n", hipGetErrorString(e), grid_blocks);
#endif
}
```

```cpp
#include <hip/hip_runtime.h>
#include <hip/hip_cooperative_groups.h>
#include <cstdio>
namespace cg = cooperative_groups;

typedef unsigned short u16;
typedef __attribute__((ext_vector_type(8))) short bf16x8;
typedef __attribute__((ext_vector_type(4))) float f32x4;

#ifndef PROBE_DUP
#define PROBE_DUP 0
#endif
#ifndef MULTI_LAUNCH
#define MULTI_LAUNCH 0
#endif

constexpr int NTOK = 16640;
constexpr int NPT = 16384;
constexpr int DM = 1024;
constexpr int DIN = 12432;
constexpr int LDY = 6400;
constexpr int YQ = 0, YK = 512, YV = 1024, YGD = 2048, YXL = 2176, YRW = 3200;
constexpr int NMT = 130;
constexpr int NGJOB = 1056;

constexpr long O_YP = 0, O_YS = 16777216, O_GLAP = 17039360, O_LHP = 19136512, O_LCP = 19152896,
               O_RWP = 19202048, O_RSP = 20250624, O_GLAS = 20301824, O_LHS = 24496128, O_LCS = 24528896,
               O_RWS = 24627200, O_RSS = 26724352;

constexpr size_t al256(size_t x) { return (x + 255) & ~(size_t)255; }
constexpr size_t WS_X = 4096;
constexpr size_t WS_XN = al256(WS_X + (size_t)NTOK * DM * 4);
constexpr size_t WS_Y = al256(WS_XN + (size_t)NTOK * DM * 2);
constexpr size_t WS_WTIN = al256(WS_Y + (size_t)NTOK * LDY * 2 + 65536);
constexpr size_t WS_WTP = al256(WS_WTIN + (size_t)12544 * 1024 * 2);
constexpr size_t WS_WTLRU = al256(WS_WTP + (size_t)16 * 1024 * 1024 * 2);
constexpr size_t WS_WTRW = al256(WS_WTLRU + (size_t)4 * 2 * 8 * 16384 * 2);
constexpr size_t WS_OG = al256(WS_WTRW + (size_t)4 * 2 * 65536 * 2);
constexpr size_t WS_OL = al256(WS_OG + (size_t)NTOK * DM * 2);
constexpr size_t WS_OR = al256(WS_OL + (size_t)NTOK * DM * 2);
constexpr size_t WS_XC = al256(WS_OR + (size_t)NTOK * DM * 2);
constexpr size_t WS_GST = al256(WS_XC + (size_t)NTOK * DM * 2);
constexpr size_t WS_GDEC = al256(WS_GST + (size_t)NGJOB * 32768 * 2);
constexpr size_t WS_LLA = al256(WS_GDEC + (size_t)NGJOB * 128 * 4);
constexpr size_t WS_LVV = al256(WS_LLA + (size_t)NTOK * DM * 2);
constexpr size_t WS_LCH = al256(WS_LVV + (size_t)NTOK * DM * 2);
constexpr size_t WS_RWW = al256(WS_LCH + (size_t)256 * 1024 * 2 * 4);
constexpr size_t WS_RWA = al256(WS_RWW + (size_t)NTOK * DM * 4);
constexpr size_t WS_RT = al256(WS_RWA + (size_t)NTOK * DM * 2);
constexpr size_t WS_CSP = al256(WS_RT + (size_t)NTOK * 128 * 2);
constexpr size_t WS_CTL = al256(WS_CSP + 4096 * 4);
constexpr int CTL_CLAIM = 0;
constexpr int CTL_QP = 8 * 4096;
constexpr int CTL_QS = CTL_QP + 8;
constexpr int CTL_QG = CTL_QS + 8;
constexpr int CTL_ROLE = CTL_QG + 64;
constexpr int CTL_NCU = CTL_ROLE + 8 * 4096;
constexpr int CTL_WORDS = CTL_NCU + 8;
constexpr size_t WS_BAR = al256(WS_CTL + (size_t)CTL_WORDS * 4);
constexpr int HB_WORDS = 64 * 50;
constexpr size_t WS_END = al256(WS_BAR + (size_t)HB_WORDS * 4);

struct Params {
  const float* in[34];
  float* out;
  unsigned char* ws;
  int ph0, ph1;
};

struct Ctx { int tid, bid, nb; unsigned char* ws; float* out; };
#define TID (cx.tid)
#define BID (cx.bid)
#define NBLK (cx.nb)
extern __shared__ __attribute__((aligned(16))) unsigned char smem[];
constexpr int SMEM_CTL = 72 * 1024;
constexpr int SMEM_BYTES = SMEM_CTL + 64;

__device__ __forceinline__ u16 f2bf(float f) {
  unsigned u = __float_as_uint(f);
  u += 0x7fffu + ((u >> 16) & 1u);
  return (u16)(u >> 16);
}
__device__ __forceinline__ float bf2f(u16 h) { return __uint_as_float(((unsigned)h) << 16); }
__device__ __forceinline__ float sigmoidf_(float x) { return 1.f / (1.f + __expf(-x)); }
__device__ __forceinline__ float siluf_(float x) { return x / (1.f + __expf(-x)); }
__device__ __forceinline__ float logsigmoidf_(float x) { return fminf(x, 0.f) - __logf(1.f + __expf(-fabsf(x))); }

__device__ __forceinline__ float dppf(float x, const int ctrl) {
  return x;
}
#define DPP_ADD(x, ctrl) x += __int_as_float(__builtin_amdgcn_update_dpp(0, __float_as_int(x), ctrl, 0xF, 0xF, true))
__device__ __forceinline__ float row16_allsum(float x) {
  DPP_ADD(x, 0xB1);
  DPP_ADD(x, 0x4E);
  DPP_ADD(x, 0x141);
  DPP_ADD(x, 0x140);
  return x;
}
__device__ __forceinline__ float wave_allsum(float x) {
#pragma unroll
  for (int o = 32; o >= 1; o >>= 1) x += __shfl_xor(x, o);
  return x;
}

__device__ __forceinline__ void gemm_mainloop(const Ctx& cx, f32x4 (&acc)[4][4], const u16* Ag, int lda, const u16* Bg, int ldb, int K) {
  const int tid = TID, wid = tid >> 6, lane = tid & 63, wr = wid >> 1, wc = wid & 1, fr = lane & 15, fq = lane >> 4;
  const int nk = K >> 6;
  const int lr0 = tid >> 3, lc = ((tid & 7) ^ ((tid >> 4) & 7)) * 8;
  const u16* ga = Ag + (long)lr0 * lda + lc;
  const u16* gb = Bg + (long)lr0 * ldb + lc;
  const int swz = (fr >> 1) & 7;
#define G_ISSUE(kt_, buf_)                                                                                                   \
  {                                                                                                                          \
    unsigned char* d_ = smem + (buf_) * 32768 + tid * 16;                                                                    \
    _Pragma("unroll") for (int i = 0; i < 4; ++i) {                                                                          \
      __builtin_amdgcn_global_load_lds((const unsigned*)(ga + (long)(i * 32) * lda + (kt_) * 64),                            \
                                       (__attribute__((address_space(3))) unsigned*)(d_ + i * 4096), 16, 0, 0);              \
      __builtin_amdgcn_global_load_lds((const unsigned*)(gb + (long)(i * 32) * ldb + (kt_) * 64),                            \
                                       (__attribute__((address_space(3))) unsigned*)(d_ + 16384 + i * 4096), 16, 0, 0);      \
    }                                                                                                                        \
  }
  G_ISSUE(0, 0)
  asm volatile("s_waitcnt vmcnt(0)" ::: "memory");
  __syncthreads();
  for (int kt = 0; kt < nk; ++kt) {
    if (kt + 1 < nk) G_ISSUE(kt + 1, (kt + 1) & 1)
    const unsigned char* SA = smem + (kt & 1) * 32768;
    const unsigned char* SB = SA + 16384;
#pragma unroll
    for (int ks = 0; ks < 2; ++ks) {
      const int co = ((ks * 4 + fq) ^ swz) * 16;
      bf16x8 At[4], Bt[4];
#pragma unroll
      for (int m = 0; m < 4; ++m) At[m] = *(const bf16x8*)(SA + (wr * 64 + m * 16 + fr) * 128 + co);
#pragma unroll
      for (int n = 0; n < 4; ++n) Bt[n] = *(const bf16x8*)(SB + (wc * 64 + n * 16 + fr) * 128 + co);
#pragma unroll
      for (int m = 0; m < 4; ++m)
#pragma unroll
        for (int n = 0; n < 4; ++n) acc[m][n] = __builtin_amdgcn_mfma_f32_16x16x32_bf16(Bt[n], At[m], acc[m][n], 0, 0, 0);
    }
    asm volatile("s_waitcnt vmcnt(0)" ::: "memory");
    __syncthreads();
  }
#undef G_ISSUE
}
__device__ __forceinline__ void gemm_mainloop3(const Ctx& cx, f32x4 (&acc)[5][4], const u16* Ag, int lda, const u16* Bg, int ldb, int K) {
  const int tid = TID, wid = tid >> 6, lane = tid & 63, wr = wid >> 1, wc = wid & 1, fr = lane & 15, fq = lane >> 4;
  const int nk = K >> 6;
  const int lr0 = tid >> 3, lc = ((tid & 7) ^ ((tid >> 4) & 7)) * 8;
  const u16* ga = Ag + (long)lr0 * lda + lc;
  const u16* gb = Bg + (long)lr0 * ldb + lc;
  const int swz = (fr >> 1) & 7;
#define G3_ISSUE(kt_, buf_)                                                                                                  \
  {                                                                                                                          \
    unsigned char* d_ = smem + (buf_) * 36864 + tid * 16;                                                                    \
    _Pragma("unroll") for (int i = 0; i < 5; ++i)                                                                            \
      __builtin_amdgcn_global_load_lds((const unsigned*)(ga + (long)(i * 32) * lda + (kt_) * 64),                            \
                                       (__attribute__((address_space(3))) unsigned*)(d_ + i * 4096), 16, 0, 0);              \
    _Pragma("unroll") for (int i = 0; i < 4; ++i)                                                                            \
      __builtin_amdgcn_global_load_lds((const unsigned*)(gb + (long)(i * 32) * ldb + (kt_) * 64),                            \
                                       (__attribute__((address_space(3))) unsigned*)(d_ + 20480 + i * 4096), 16, 0, 0);      \
  }
  G3_ISSUE(0, 0)
  asm volatile("s_waitcnt vmcnt(0)" ::: "memory");
  __syncthreads();
  for (int kt = 0; kt < nk; ++kt) {
    if (kt + 1 < nk) G3_ISSUE(kt + 1, (kt + 1) & 1)
    const unsigned char* SA = smem + (kt & 1) * 36864;
    const unsigned char* SB = SA + 20480;
#pragma unroll
    for (int ks = 0; ks < 2; ++ks) {
      const int co = ((ks * 4 + fq) ^ swz) * 16;
      bf16x8 At[5], Bt[4];
#pragma unroll
      for (int m = 0; m < 5; ++m) At[m] = *(const bf16x8*)(SA + (wr * 80 + m * 16 + fr) * 128 + co);
#pragma unroll
      for (int n = 0; n < 4; ++n) Bt[n] = *(const bf16x8*)(SB + (wc * 64 + n * 16 + fr) * 128 + co);
#pragma unroll
      for (int m = 0; m < 5; ++m)
#pragma unroll
        for (int n = 0; n < 4; ++n) acc[m][n] = __builtin_amdgcn_mfma_f32_16x16x32_bf16(Bt[n], At[m], acc[m][n], 0, 0, 0);
    }
    asm volatile("s_waitcnt vmcnt(0)" ::: "memory");
    __syncthreads();
  }
#undef G3_ISSUE
}
__device__ __forceinline__ void acc_zero5(f32x4 (&acc)[5][4]) {
#pragma unroll
  for (int m = 0; m < 5; ++m)
#pragma unroll
    for (int n = 0; n < 4; ++n) acc[m][n] = (f32x4){0.f, 0.f, 0.f, 0.f};
}
#define EPI5_BEGIN                                                                                          \
  {                                                                                                         \
    int e_z = 0; asm volatile("" : "+v"(e_z));                                                              \
    const int e_tid = TID + e_z, e_wid = e_tid >> 6, e_lane = e_tid & 63, e_wr = e_wid >> 1, e_wc = e_wid & 1, \
              e_fr = e_lane & 15, e_fq = e_lane >> 4;                                                       \
    _Pragma("unroll") for (int m = 0; m < 5; ++m) { __builtin_amdgcn_sched_barrier(0);                      \
      _Pragma("unroll") for (int n = 0; n < 4; ++n) {                                                       \
      const int lrow = e_wr * 80 + m * 16 + e_fr;                                                           \
      const int lcol = e_wc * 64 + n * 16 + e_fq * 4;                                                       \
      const f32x4 v = acc[m][n];
#define EPI5_END \
  }              \
  }              \
  }
constexpr int NMT3 = 104;
__device__ __forceinline__ void acc_zero(f32x4 (&acc)[4][4]) {
#pragma unroll
  for (int m = 0; m < 4; ++m)
#pragma unroll
    for (int n = 0; n < 4; ++n) acc[m][n] = (f32x4){0.f, 0.f, 0.f, 0.f};
}
#define EPI4_BEGIN                                                                                          \
  {                                                                                                         \
    int e_z = 0; asm volatile("" : "+v"(e_z));                                                              \
    const int e_tid = TID + e_z, e_wid = e_tid >> 6, e_lane = e_tid & 63, e_wr = e_wid >> 1, e_wc = e_wid & 1, \
              e_fr = e_lane & 15, e_fq = e_lane >> 4;                                                       \
    _Pragma("unroll") for (int m = 0; m < 4; ++m) { __builtin_amdgcn_sched_barrier(0);                      \
      _Pragma("unroll") for (int n = 0; n < 4; ++n) {                                                       \
      const int lrow = e_wr * 64 + m * 16 + e_fr;                                                           \
      const int lcol = e_wc * 64 + n * 16 + e_fq * 4;                                                       \
      const f32x4 v = acc[m][n];
#define EPI4_END \
  }              \
  }              \
  }
__device__ __forceinline__ ushort4 pack4(float a, float b, float c, float d) {
  ushort4 o; o.x = f2bf(a); o.y = f2bf(b); o.z = f2bf(c); o.w = f2bf(d); return o;
}

__device__ __forceinline__ void tok_decode(int tok, int& seq, int& pos, int& L) {
  if (tok < NPT) { seq = tok >> 12; pos = tok & 4095; L = 4096; }
  else { int t = tok - NPT; seq = 4 + (t >> 5); pos = t & 31; L = 32; }
}

__device__ __forceinline__ void tconv_block(const float* __restrict__ src, long ldsrc, int n_src, int k8, u16* __restrict__ dst, int n_dst, long lddst) {
  float4 r[8];
#pragma unroll
  for (int j = 0; j < 8; ++j) r[j] = (n_src >= 0) ? *(const float4*)(src + (long)(k8 * 8 + j) * ldsrc + n_src) : make_float4(0.f, 0.f, 0.f, 0.f);
  bf16x8 v0, v1, v2, v3;
#pragma unroll
  for (int j = 0; j < 8; ++j) { v0[j] = (short)f2bf(r[j].x); v1[j] = (short)f2bf(r[j].y); v2[j] = (short)f2bf(r[j].z); v3[j] = (short)f2bf(r[j].w); }
  *(bf16x8*)(dst + (long)(n_dst + 0) * lddst + k8 * 8) = v0;
  *(bf16x8*)(dst + (long)(n_dst + 1) * lddst + k8 * 8) = v1;
  *(bf16x8*)(dst + (long)(n_dst + 2) * lddst + k8 * 8) = v2;
  *(bf16x8*)(dst + (long)(n_dst + 3) * lddst + k8 * 8) = v3;
}
__device__ __forceinline__ void tconv(const Ctx& cx, const float* __restrict__ src, int K, int N, u16* __restrict__ dst) {
  const int ng = N >> 2, items = ng * (K >> 3);
  for (int it = BID * 256 + TID; it < items; it += NBLK * 256) {
    const int g = it % ng, k8 = it / ng;
    tconv_block(src, N, g * 4, k8, dst, g * 4, K);
  }
}

__device__ __forceinline__ void phase_convw(const Ctx& cx, const Params& p) {
  u16* WTP = (u16*)(cx.ws + WS_WTP);
  u16* WTLRU = (u16*)(cx.ws + WS_WTLRU);
  u16* WTRW = (u16*)(cx.ws + WS_WTRW);
  for (int it = BID * 256 + TID; it < CTL_WORDS; it += NBLK * 256) ((int*)(cx.ws + WS_CTL))[it] = 0;
  for (int it = BID * 256 + TID; it < HB_WORDS; it += NBLK * 256) ((unsigned*)(cx.ws + WS_BAR))[it] = 0u;
  for (int it = BID * 256 + TID; it < 4096; it += NBLK * 256) {
    const float nl = -p.in[18][it];
    ((float*)(cx.ws + WS_CSP))[it] = -8.f * (fmaxf(nl, 0.f) + log1pf(__expf(-fabsf(nl))));
  }
  for (int l = 0; l < 4; ++l) {
    tconv(cx, p.in[29] + (long)l * 1048576, 1024, 1024, WTP + (long)(l * 4 + 0) * 1048576);
    tconv(cx, p.in[30] + (long)l * 1048576, 1024, 1024, WTP + (long)(l * 4 + 1) * 1048576);
    tconv(cx, p.in[31] + (long)l * 1048576, 1024, 1024, WTP + (long)(l * 4 + 2) * 1048576);
    tconv(cx, p.in[32] + (long)l * 1048576, 1024, 1024, WTP + (long)(l * 4 + 3) * 1048576);
    for (int n = 0; n < 8; ++n) {
      tconv(cx, p.in[14] + (long)(l * 8 + n) * 16384, 128, 128, WTLRU + (long)((l * 2 + 0) * 8 + n) * 16384);
      tconv(cx, p.in[16] + (long)(l * 8 + n) * 16384, 128, 128, WTLRU + (long)((l * 2 + 1) * 8 + n) * 16384);
    }
    tconv(cx, p.in[21] + (long)l * 65536, 64, 1024, WTRW + (long)(l * 2 + 0) * 65536);
    tconv(cx, p.in[23] + (long)l * 65536, 64, 1024, WTRW + (long)(l * 2 + 1) * 65536);
  }
}

__device__ __forceinline__ void phase_norm(const Ctx& cx, const Params& p, int l) {
  float* X = (float*)(cx.ws + WS_X);
  u16* XN = (u16*)(cx.ws + WS_XN);
  const int lane = TID & 63;
  const float* g = (l < 4) ? (p.in[7] + l * 1024) : p.in[33];
  for (int row = BID * 4 + (TID >> 6); row < NTOK; row += NBLK * 4) {
    const float* src = (l == 0) ? (row < NPT ? p.in[0] + (long)row * 1024 : p.in[1] + (long)(row - NPT) * 1024) : X + (long)row * 1024;
    float4 v[4];
    float ss = 0.f;
#pragma unroll
    for (int i = 0; i < 4; ++i) {
      v[i] = ((const float4*)src)[lane + 64 * i];
      ss += v[i].x * v[i].x + v[i].y * v[i].y + v[i].z * v[i].z + v[i].w * v[i].w;
    }
    ss = wave_allsum(ss);
    const float r = rsqrtf(ss * (1.f / 1024.f) + 1e-6f);
#pragma unroll
    for (int i = 0; i < 4; ++i) {
      const int c = (lane + 64 * i) * 4;
      float4 gg = *(const float4*)(g + c);
      float4 o;
      o.x = v[i].x * r * gg.x; o.y = v[i].y * r * gg.y; o.z = v[i].z * r * gg.z; o.w = v[i].w * r * gg.w;
      if (l == 0) ((float4*)(X + (long)row * 1024))[lane + 64 * i] = v[i];
      if (l < 4) {
        ushort4 ob;
        ob.x = f2bf(o.x); ob.y = f2bf(o.y); ob.z = f2bf(o.z); ob.w = f2bf(o.w);
        *(ushort4*)(XN + (long)row * 1024 + c) = ob;
      } else {
        float* dst = (row < NPT) ? (cx.out + O_YP + (long)row * 1024) : (cx.out + O_YS + (long)(row - NPT) * 1024);
        *(float4*)(dst + c) = o;
      }
    }
  }
  if (l < 4) {
    const float* W = p.in[8] + (long)l * 1024 * DIN;
    u16* WT = (u16*)(cx.ws + WS_WTIN);
    const int items = (12544 / 4) * 128;
    for (int it = BID * 256 + TID; it < items; it += NBLK * 256) {
      const int g = it % 3136, k8 = it / 3136, n = g * 4;
      int sc;
      if (n < 6400) {
        if (n < 2064) sc = n;
        else if (n < 2176) sc = -1;
        else if (n < 3200) sc = 3088 + (n - 2176);
        else sc = 5136 + (n - 3200);
      } else {
        const int q = n - 6400;
        if (q < 1024) sc = 2064 + q;
        else if (q < 2048) sc = 4112 + (q - 1024);
        else if (q < 3072) sc = 8336 + (q - 2048);
        else sc = 9360 + (q - 3072);
      }
      tconv_block(W, DIN, sc, k8, WT, n, 1024);
    }
  }
}

#define TILE_LOOP_BEGIN(NT_)                                                                \
  {                                                                                         \
    const int tl_total = NMT * (NT_), tl_per = NBLK >> 3, tl_x = BID & 7, tl_l = BID >> 3;  \
    const int tl_full = (NT_) >> 3;                                                         \
    for (int tl_it = 0;; ++tl_it) {                                                         \
      const int tl_base = (tl_it * 8 + tl_x) * tl_per;                                      \
      if (tl_it * 8 * tl_per >= tl_total) break;                                            \
      const int t = tl_base + tl_l;                                                         \
      if (t >= tl_total) continue;                                                          \
      int mt, nt;                                                                           \
      if (t < tl_full * (NMT * 8)) { const int sn = t / (NMT * 8), r = t % (NMT * 8); mt = r >> 3; nt = sn * 8 + (r & 7); } \
      else { const int r = t - tl_full * (NMT * 8), wn = (NT_) - tl_full * 8; mt = r / wn; nt = tl_full * 8 + r % wn; }
#define TILE3_LOOP_BEGIN(NT_)                                                                \
  {                                                                                         \
    const int tl_total = NMT3 * (NT_), tl_per = NBLK >> 3, tl_x = BID & 7, tl_l = BID >> 3;  \
    const int tl_full = (NT_) >> 3;                                                         \
    for (int tl_it = 0;; ++tl_it) {                                                         \
      const int tl_base = (tl_it * 8 + tl_x) * tl_per;                                      \
      if (tl_it * 8 * tl_per >= tl_total) break;                                            \
      const int t = tl_base + tl_l;                                                         \
      if (t >= tl_total) continue;                                                          \
      int mt, nt;                                                                           \
      if (t < tl_full * (NMT3 * 8)) { const int sn = t / (NMT3 * 8), r = t % (NMT3 * 8); mt = r >> 3; nt = sn * 8 + (r & 7); } \
      else { const int r = t - tl_full * (NMT3 * 8), wn = (NT_) - tl_full * 8; mt = r / wn; nt = tl_full * 8 + r % wn; }
#define TILE_LOOP_END \
    }                 \
  }

__device__ __forceinline__ void phase_inproj1(const Ctx& cx, const Params& p) {
  const u16* XN = (const u16*)(cx.ws + WS_XN);
  const u16* WT = (const u16*)(cx.ws + WS_WTIN);
  u16* Y = (u16*)(cx.ws + WS_Y);
  TILE_LOOP_BEGIN(50)
    f32x4 acc[4][4];
    acc_zero(acc);
    gemm_mainloop(cx, acc, XN + (long)mt * 128 * 1024, 1024, WT + (long)nt * 128 * 1024, 1024, 1024);
    EPI4_BEGIN
      *(ushort4*)(Y + (long)(mt * 128 + lrow) * LDY + nt * 128 + lcol) = pack4(v[0], v[1], v[2], v[3]);
    EPI4_END
  TILE_LOOP_END
}

__device__ __forceinline__ void phase_prep(const Ctx& cx, const Params& p, int l) {
  const u16* __restrict__ Y = (const u16*)(cx.ws + WS_Y);
  u16* __restrict__ XC = (u16*)(cx.ws + WS_XC);
  u16* __restrict__ RT = (u16*)(cx.ws + WS_RT);
  const int gtid = BID * 256 + TID, gstr = NBLK * 256;
  const float* cw = p.in[12] + l * 4096;
  const float* cb = p.in[13] + l * 1024;
#pragma unroll 2
  for (int it = gtid; it < NTOK * 128; it += gstr) {
    const int tok = it >> 7, c = (it & 127) * 8;
    int seq, pos, L;
    tok_decode(tok, seq, pos, L);
    float a[8], cur[8];
    {
      const float4 b0 = *(const float4*)(cb + c), b1 = *(const float4*)(cb + c + 4);
      a[0] = b0.x; a[1] = b0.y; a[2] = b0.z; a[3] = b0.w; a[4] = b1.x; a[5] = b1.y; a[6] = b1.z; a[7] = b1.w;
    }
#pragma unroll
    for (int t = 0; t < 4; ++t) {
      const int pp = pos - 3 + t;
      float x[8];
      if (pp >= 0) {
        const bf16x8 xv = *(const bf16x8*)(Y + (long)(tok - 3 + t) * LDY + YXL + c);
#pragma unroll
        for (int j = 0; j < 8; ++j) x[j] = bf2f((u16)xv[j]);
      } else if (seq >= 4) {
        const float* s_ = p.in[4] + ((long)((l * 8 + (seq - 4)) * 3 + (pos + t))) * 1024 + c;
#pragma unroll
        for (int j = 0; j < 8; ++j) x[j] = s_[j];
      } else {
#pragma unroll
        for (int j = 0; j < 8; ++j) x[j] = 0.f;
      }
      const float4 w0 = *(const float4*)(cw + t * 1024 + c), w1 = *(const float4*)(cw + t * 1024 + c + 4);
      a[0] += w0.x * x[0]; a[1] += w0.y * x[1]; a[2] += w0.z * x[2]; a[3] += w0.w * x[3];
      a[4] += w1.x * x[4]; a[5] += w1.y * x[5]; a[6] += w1.z * x[6]; a[7] += w1.w * x[7];
      if (t == 3) {
#pragma unroll
        for (int j = 0; j < 8; ++j) cur[j] = x[j];
      }
    }
    bf16x8 o;
#pragma unroll
    for (int j = 0; j < 8; ++j) o[j] = (short)f2bf(a[j]);
    *(bf16x8*)(XC + (long)tok * 1024 + c) = o;
    if (pos >= L - 3) {
      const int jj = pos - (L - 3);
      float* dst = (seq < 4) ? (cx.out + O_LCP + ((long)((l * 4 + seq) * 3 + jj)) * 1024 + c)
                             : (cx.out + O_LCS + ((long)((l * 8 + (seq - 4)) * 3 + jj)) * 1024 + c);
      *(float4*)dst = make_float4(cur[0], cur[1], cur[2], cur[3]);
      *(float4*)(dst + 4) = make_float4(cur[4], cur[5], cur[6], cur[7]);
    }
  }
  const float* mu = p.in[19] + l * 3200;
#pragma unroll 4
  for (int it = gtid; it < NTOK * 128; it += gstr) {
    const int tok = it >> 7, c = it & 127;
    int seq, pos, L;
    tok_decode(tok, seq, pos, L);
    const float cur = bf2f(Y[(long)tok * LDY + YRW + 3072 + c]);
    float prev;
    if (pos > 0) prev = bf2f(Y[(long)(tok - 1) * LDY + YRW + 3072 + c]);
    else if (seq >= 4) prev = p.in[6][(long)(l * 8 + (seq - 4)) * 3200 + 3072 + c];
    else prev = 0.f;
    const float xs = cur + (prev - cur) * mu[3072 + c];
    RT[(long)tok * 128 + c] = f2bf(c < 64 ? tanhf(xs) : xs);
  }
  for (int it = gtid; it < 12 * 3200; it += gstr) {
    const int seq = it / 3200, c = it % 3200;
    const int last = (seq < 4) ? (seq * 4096 + 4095) : (NPT + (seq - 4) * 32 + 31);
    const float v = bf2f(Y[(long)last * LDY + YRW + c]);
    if (seq < 4) cx.out[O_RSP + (long)(l * 4 + seq) * 3200 + c] = v;
    else cx.out[O_RSS + (long)(l * 8 + (seq - 4)) * 3200 + c] = v;
  }
}

__device__ __forceinline__ void gla_job_decode(int job, int& seq, int& h, int& tok0, int& valid) {
  if (job < 1024) { seq = job >> 8; int rem = job & 255; h = rem & 3; tok0 = seq * 4096 + (rem >> 2) * 64; valid = 64; }
  else { int j = job - 1024; seq = 4 + (j >> 2); h = j & 3; tok0 = NPT + (seq - 4) * 32; valid = 32; }
}
constexpr int G_SGD = 0;
constexpr int G_SHT = 4096;
constexpr int G_SSS = 5120;
constexpr int G_QD = 6144;
constexpr int G_KN = G_QD + 17408;
constexpr int G_P = G_KN + 17408;
constexpr int GS = 136, PS = 72;

#define GLA_LA(i_, valid_)                                                                       \
  ({                                                                                             \
    float x_ = g_bg;                                                                             \
    _Pragma("unroll") for (int r4 = 0; r4 < 4; ++r4) {                                           \
      const float4 gv = *(const float4*)(sGD + (i_) * 16 + r4 * 4);                              \
      x_ += gv.x * g_wg[r4 * 4] + gv.y * g_wg[r4 * 4 + 1] + gv.z * g_wg[r4 * 4 + 2] + gv.w * g_wg[r4 * 4 + 3]; \
    }                                                                                            \
    float la_ = logsigmoidf_(x_) * (1.f / 16.f);                                                 \
    if ((i_) >= (valid_)) la_ = 0.f;                                                             \
    la_;                                                                                         \
  })
#define GLA_CUMSUM(l_, h_, tok0_, valid_)                                                                          \
  const int g_tid = TID, g_d = g_tid & 127, g_half = g_tid >> 7;                                                    \
  float* sGD = (float*)(smem + G_SGD);                                                                              \
  float* sHT = (float*)(smem + G_SHT);                                                                              \
  {                                                                                                                 \
    _Pragma("unroll") for (int q = 0; q < 4; ++q) {                                                                 \
      const int idx = g_tid * 4 + q, i = idx >> 4, r = idx & 15;                                                    \
      const int ti = (i < valid_) ? i : (valid_ - 1);                                                               \
      sGD[idx] = bf2f(Y[(long)(tok0_ + ti) * LDY + YGD + r]);                                                       \
    }                                                                                                               \
  }                                                                                                                 \
  float g_wg[16];                                                                                                   \
  _Pragma("unroll") for (int r = 0; r < 16; ++r) g_wg[r] = p.in[9][(long)(l_ * 16 + r) * 512 + h_ * 128 + g_d];      \
  const float g_bg = p.in[10][l_ * 512 + h_ * 128 + g_d];                                                           \
  __syncthreads();                                                                                                  \
  {                                                                                                                 \
    float run = 0.f;                                                                                                \
    _Pragma("unroll 2") for (int ii = 0; ii < 32; ++ii) run += GLA_LA(g_half * 32 + ii, valid_);                    \
    sHT[g_half * 128 + g_d] = run;                                                                                  \
  }                                                                                                                 \
  __syncthreads();                                                                                                  \
  const float g_off = g_half ? sHT[g_d] : 0.f;                                                                      \
  const float g_bend = sHT[g_d] + sHT[128 + g_d];

__device__ __forceinline__ void gla_phase_a(const Ctx& cx, const Params& p, int l, int job) {
  const u16* Y = (const u16*)(cx.ws + WS_Y);
  u16* GST = (u16*)(cx.ws + WS_GST);
  float* GDEC = (float*)(cx.ws + WS_GDEC);
  int seq, h, tok0, valid;
  gla_job_decode(job, seq, h, tok0, valid);
  __syncthreads();
  GLA_CUMSUM(l, h, tok0, valid)
  u16* sKd = (u16*)(smem + G_QD);
  {
    float run = g_off;
#pragma unroll 4
    for (int ii = 0; ii < 32; ++ii) {
      const int i = g_half * 32 + ii;
      run += GLA_LA(i, valid);
      float kv = 0.f;
      if (i < valid) kv = bf2f(Y[(long)(tok0 + i) * LDY + YK + h * 128 + g_d]);
      sKd[i * GS + g_d] = f2bf(kv * __expf(g_bend - run));
    }
  }
  if (g_half == 0) GDEC[job * 128 + g_d] = __expf(g_bend);
  __syncthreads();
  const int wid = g_tid >> 6, lane = g_tid & 63, fr = lane & 15, fq = lane >> 4;
  bf16x8 Af[4][2];
#pragma unroll
  for (int mt = 0; mt < 4; ++mt)
#pragma unroll
    for (int ks = 0; ks < 2; ++ks)
#pragma unroll
      for (int jj = 0; jj < 8; ++jj) {
        int jrow = ks * 32 + fq * 8 + jj;
        jrow = jrow < valid ? jrow : valid - 1;
        Af[mt][ks][jj] = (short)Y[(long)(tok0 + jrow) * LDY + YV + h * 256 + wid * 64 + mt * 16 + fr];
      }
#pragma unroll 1
  for (int nt = 0; nt < 8; ++nt) {
    bf16x8 Bf[2];
#pragma unroll
    for (int ks = 0; ks < 2; ++ks)
#pragma unroll
      for (int jj = 0; jj < 8; ++jj) Bf[ks][jj] = (short)sKd[(ks * 32 + fq * 8 + jj) * GS + nt * 16 + fr];
    f32x4 acc[4];
#pragma unroll
    for (int mt = 0; mt < 4; ++mt) {
      acc[mt] = (f32x4){0.f, 0.f, 0.f, 0.f};
#pragma unroll
      for (int ks = 0; ks < 2; ++ks) acc[mt] = __builtin_amdgcn_mfma_f32_16x16x32_bf16(Af[mt][ks], Bf[ks], acc[mt], 0, 0, 0);
    }
#pragma unroll
    for (int mt = 0; mt < 4; ++mt)
#pragma unroll
      for (int jj = 0; jj < 4; ++jj) {
        const int er = wid * 64 + mt * 16 + fq * 4 + jj;
        GST[(long)job * 32768 + er * 128 + nt * 16 + fr] = f2bf(acc[mt][jj]);
      }
  }
}

__device__ __forceinline__ void gla_phase_c(const Ctx& cx, const Params& p, int l, int job) {
  const u16* Y = (const u16*)(cx.ws + WS_Y);
  const u16* GST = (const u16*)(cx.ws + WS_GST);
  u16* OG = (u16*)(cx.ws + WS_OG);
  int seq, h, tok0, valid;
  gla_job_decode(job, seq, h, tok0, valid);
  __syncthreads();
  GLA_CUMSUM(l, h, tok0, valid)
  (void)g_bend;
  u16* sQd = (u16*)(smem + G_QD);
  u16* sKn = (u16*)(smem + G_KN);
  u16* sP = (u16*)(smem + G_P);
  float* sSS = (float*)(smem + G_SSS);
  {
    float run = g_off;
#pragma unroll 4
    for (int ii = 0; ii < 32; ++ii) {
      const int i = g_half * 32 + ii;
      run += GLA_LA(i, valid);
      float qv = 0.f, kv = 0.f;
      if (i < valid) {
        qv = bf2f(Y[(long)(tok0 + i) * LDY + YQ + h * 128 + g_d]);
        kv = bf2f(Y[(long)(tok0 + i) * LDY + YK + h * 128 + g_d]);
      }
      sQd[i * GS + g_d] = f2bf(qv * __expf(run) * 0.08838834764831845f);
      sKn[i * GS + g_d] = f2bf(kv * __expf(-run));
    }
  }
  __syncthreads();
  const int wid = g_tid >> 6, lane = g_tid & 63, fr = lane & 15, fq = lane >> 4;
  {
    f32x4 sc[4];
#pragma unroll
    for (int jt = 0; jt < 4; ++jt) sc[jt] = (f32x4){0.f, 0.f, 0.f, 0.f};
#pragma unroll
    for (int ks = 0; ks < 4; ++ks) {
      bf16x8 a = *(const bf16x8*)(sQd + (wid * 16 + fr) * GS + ks * 32 + fq * 8);
#pragma unroll
      for (int jt = 0; jt < 4; ++jt) {
        bf16x8 b = *(const bf16x8*)(sKn + (jt * 16 + fr) * GS + ks * 32 + fq * 8);
        sc[jt] = __builtin_amdgcn_mfma_f32_16x16x32_bf16(a, b, sc[jt], 0, 0, 0);
      }
    }
#pragma unroll
    for (int jt = 0; jt < 4; ++jt)
#pragma unroll
      for (int jj = 0; jj < 4; ++jj) {
        const int i = wid * 16 + fq * 4 + jj, j = jt * 16 + fr;
        sP[i * PS + j] = f2bf(j <= i ? sc[jt][jj] : 0.f);
      }
  }
  __syncthreads();
  f32x4 acc[4][4];
  acc_zero(acc);
#pragma unroll 1
  for (int ks = 0; ks < 4; ++ks) {
    bf16x8 a[4];
#pragma unroll
    for (int mt = 0; mt < 4; ++mt) a[mt] = *(const bf16x8*)(sQd + (mt * 16 + fr) * GS + ks * 32 + fq * 8);
#pragma unroll
    for (int nt = 0; nt < 4; ++nt) {
      const bf16x8 b = *(const bf16x8*)(GST + (long)job * 32768 + (wid * 64 + nt * 16 + fr) * 128 + ks * 32 + fq * 8);
#pragma unroll
      for (int mt = 0; mt < 4; ++mt) acc[mt][nt] = __builtin_amdgcn_mfma_f32_16x16x32_bf16(a[mt], b, acc[mt][nt], 0, 0, 0);
    }
  }
#pragma unroll 1
  for (int ks = 0; ks < 2; ++ks) {
    bf16x8 a[4];
#pragma unroll
    for (int mt = 0; mt < 4; ++mt) a[mt] = *(const bf16x8*)(sP + (mt * 16 + fr) * PS + ks * 32 + fq * 8);
#pragma unroll
    for (int nt = 0; nt < 4; ++nt) {
      bf16x8 b;
#pragma unroll
      for (int jj = 0; jj < 8; ++jj) {
        int jrow = ks * 32 + fq * 8 + jj;
        jrow = jrow < valid ? jrow : valid - 1;
        b[jj] = (short)Y[(long)(tok0 + jrow) * LDY + YV + h * 256 + wid * 64 + nt * 16 + fr];
      }
#pragma unroll
      for (int mt = 0; mt < 4; ++mt) acc[mt][nt] = __builtin_amdgcn_mfma_f32_16x16x32_bf16(a[mt], b, acc[mt][nt], 0, 0, 0);
    }
  }
#pragma unroll
  for (int mt = 0; mt < 4; ++mt)
#pragma unroll
    for (int jj = 0; jj < 4; ++jj) {
      float s = 0.f;
#pragma unroll
      for (int nt = 0; nt < 4; ++nt) s += acc[mt][nt][jj] * acc[mt][nt][jj];
      s = row16_allsum(s);
      if (fr == 0) sSS[wid * 64 + mt * 16 + fq * 4 + jj] = s;
    }
  __syncthreads();
  const float* ng = p.in[11] + l * 1024 + h * 256;
#pragma unroll
  for (int mt = 0; mt < 4; ++mt)
#pragma unroll
    for (int jj = 0; jj < 4; ++jj) {
      const int i = mt * 16 + fq * 4 + jj;
      const float tot = sSS[i] + sSS[64 + i] + sSS[128 + i] + sSS[192 + i];
      const float rs = rsqrtf(tot * (1.f / 256.f) + 1e-6f);
      if (i < valid) {
#pragma unroll
        for (int nt = 0; nt < 4; ++nt) {
          const int e = wid * 64 + nt * 16 + fr;
          OG[(long)(tok0 + i) * 1024 + h * 256 + e] = f2bf(acc[mt][nt][jj] * rs * ng[e]);
        }
      }
    }
}

__device__ __forceinline__ void phase_mix1(const Ctx& cx, const Params& p, int l) {
  const int nj_gla = NGJOB, nj_lru = NMT * 8, nj_rw = NMT * 16;
  for (int job = BID; job < nj_gla + nj_lru + nj_rw; job += NBLK) {
    if (job < nj_gla) {
      gla_phase_a(cx, p, l, job);
    } else if (job < nj_gla + nj_lru) {
      const int jb = job - nj_gla, mt = jb >> 3, nb = jb & 7;
      const u16* XC = (const u16*)(cx.ws + WS_XC);
      const u16* WTL = (const u16*)(cx.ws + WS_WTLRU);
      u16* LLA = (u16*)(cx.ws + WS_LLA);
      u16* LVV = (u16*)(cx.ws + WS_LVV);
      const float* CSP = (const float*)(cx.ws + WS_CSP) + l * 1024;
      __syncthreads();
      {
        f32x4 acc[4][4];
        acc_zero(acc);
        gemm_mainloop(cx, acc, XC + (long)mt * 128 * 1024 + nb * 128, 1024, WTL + (long)((l * 2 + 0) * 8 + nb) * 16384, 128, 128);
        EPI4_BEGIN
          const int row = mt * 128 + lrow, col = nb * 128 + lcol;
          const float4 ba = *(const float4*)(p.in[15] + l * 1024 + col);
          const float4 sp = *(const float4*)(CSP + col);
          *(ushort4*)(LLA + (long)row * 1024 + col) = pack4(sigmoidf_(v[0] + ba.x) * sp.x, sigmoidf_(v[1] + ba.y) * sp.y,
                                                            sigmoidf_(v[2] + ba.z) * sp.z, sigmoidf_(v[3] + ba.w) * sp.w);
        EPI4_END
      }
      {
        f32x4 acc[4][4];
        acc_zero(acc);
        gemm_mainloop(cx, acc, XC + (long)mt * 128 * 1024 + nb * 128, 1024, WTL + (long)((l * 2 + 1) * 8 + nb) * 16384, 128, 128);
        EPI4_BEGIN
          const int row = mt * 128 + lrow, col = nb * 128 + lcol;
          const float4 bx = *(const float4*)(p.in[17] + l * 1024 + col);
          const ushort4 xc = *(const ushort4*)(XC + (long)row * 1024 + col);
          *(ushort4*)(LVV + (long)row * 1024 + col) = pack4(sigmoidf_(v[0] + bx.x) * bf2f(xc.x), sigmoidf_(v[1] + bx.y) * bf2f(xc.y),
                                                            sigmoidf_(v[2] + bx.z) * bf2f(xc.z), sigmoidf_(v[3] + bx.w) * bf2f(xc.w));
        EPI4_END
      }
    } else {
      const int jb = job - nj_gla - nj_lru, mt = jb >> 4, nt = (jb >> 1) & 7, which = jb & 1;
      const u16* RT = (const u16*)(cx.ws + WS_RT);
      const u16* WTR = (const u16*)(cx.ws + WS_WTRW);
      f32x4 acc[4][4];
      acc_zero(acc);
      __syncthreads();
      gemm_mainloop(cx, acc, RT + (long)mt * 128 * 128 + which * 64, 128, WTR + (long)(l * 2 + which) * 65536 + (long)nt * 128 * 64, 64, 64);
      if (which == 0) {
        float* RWW = (float*)(cx.ws + WS_RWW);
        EPI4_BEGIN
          const int row = mt * 128 + lrow, col = nt * 128 + lcol;
          const float4 w0 = *(const float4*)(p.in[20] + l * 1024 + col);
          float4 o;
          o.x = __expf(-sigmoidf_(w0.x + v[0]) * 0.6065306597126334f);
          o.y = __expf(-sigmoidf_(w0.y + v[1]) * 0.6065306597126334f);
          o.z = __expf(-sigmoidf_(w0.z + v[2]) * 0.6065306597126334f);
          o.w = __expf(-sigmoidf_(w0.w + v[3]) * 0.6065306597126334f);
          *(float4*)(RWW + (long)row * 1024 + col) = o;
        EPI4_END
      } else {
        u16* RWA = (u16*)(cx.ws + WS_RWA);
        EPI4_BEGIN
          const int row = mt * 128 + lrow, col = nt * 128 + lcol;
          const float4 a0 = *(const float4*)(p.in[22] + l * 1024 + col);
          *(ushort4*)(RWA + (long)row * 1024 + col) = pack4(sigmoidf_(a0.x + v[0]), sigmoidf_(a0.y + v[1]), sigmoidf_(a0.z + v[2]), sigmoidf_(a0.w + v[3]));
        EPI4_END
      }
    }
  }
}

__device__ __forceinline__ void lru_step4(const ushort4 la4, const ushort4 vv4, float (&h)[4], float (&A)[4], bool trackA) {
  const float la[4] = {bf2f(la4.x), bf2f(la4.y), bf2f(la4.z), bf2f(la4.w)};
  const float vv[4] = {bf2f(vv4.x), bf2f(vv4.y), bf2f(vv4.z), bf2f(vv4.w)};
#pragma unroll
  for (int j = 0; j < 4; ++j) {
    const float a = __expf(la[j]);
    const float u = sqrtf(fmaxf(1.f - a * a, 0.f)) * vv[j];
    if (trackA) A[j] *= a;
    h[j] = a * h[j] + u;
  }
}
__device__ __forceinline__ void phase_mix2(const Ctx& cx, const Params& p, int l, bool shadow = false) {
  u16* GST = (u16*)(cx.ws + WS_GST);
  const float* GDEC = (const float*)(cx.ws + WS_GDEC);
  const int gtid = BID * 256 + TID, gstr = NBLK * 256;
  for (int it = gtid; it < 48 * 4096; it += gstr) {
    const int sh = it >> 12, idx = (it & 4095) * 8, d = idx & 127, e = idx >> 7;
    float S[8];
    int job0, nch, jstride;
    float* outp;
    if (sh < 16) {
      const int seq = sh >> 2, h = sh & 3;
#pragma unroll
      for (int j = 0; j < 8; ++j) S[j] = 0.f;
      job0 = seq * 256 + h; nch = 64; jstride = 4;
      outp = cx.out + O_GLAP + ((long)((l * 4 + seq) * 4 + h)) * 32768 + d * 256 + e;
    } else {
      const int j_ = sh - 16, b = j_ >> 2, h = j_ & 3;
      const long so = ((long)((l * 8 + b) * 4 + h)) * 32768 + d * 256 + e;
#pragma unroll
      for (int j = 0; j < 8; ++j) S[j] = p.in[2][so + j * 256];
      job0 = 1024 + j_; nch = 1; jstride = 0;
      outp = cx.out + O_GLAS + so;
    }
    for (int ch0 = 0; ch0 < nch; ch0 += 8) {
      bf16x8 u[8];
      float4 da[8], db[8];
#pragma unroll
      for (int q = 0; q < 8; ++q) {
        if (ch0 + q < nch) {
          const int job = job0 + (ch0 + q) * jstride;
          u[q] = *(const bf16x8*)(GST + (long)job * 32768 + idx);
          da[q] = *(const float4*)(GDEC + job * 128 + d);
          db[q] = *(const float4*)(GDEC + job * 128 + d + 4);
        }
      }
#pragma unroll
      for (int q = 0; q < 8; ++q) {
        if (ch0 + q < nch) {
          const int job = job0 + (ch0 + q) * jstride;
          const float dd[8] = {da[q].x, da[q].y, da[q].z, da[q].w, db[q].x, db[q].y, db[q].z, db[q].w};
          bf16x8 o;
#pragma unroll
          for (int j = 0; j < 8; ++j) {
            o[j] = (short)f2bf(S[j]);
            S[j] = S[j] * dd[j] + bf2f((u16)u[q][j]);
          }
          if (!shadow) *(bf16x8*)(GST + (long)job * 32768 + idx) = o;
        }
      }
    }
#pragma unroll
    for (int j = 0; j < 8; ++j) outp[j * 256] = S[j];
  }
  const u16* LLA = (const u16*)(cx.ws + WS_LLA);
  const u16* LVV = (const u16*)(cx.ws + WS_LVV);
  float* LCH = (float*)(cx.ws + WS_LCH);
  for (int it = gtid; it < 4 * 64 * 256; it += gstr) {
    const int c = (it & 255) * 4, ch = (it >> 8) & 63, seq = it >> 14;
    const long t0 = (long)seq * 4096 + ch * 64;
    float A[4] = {1.f, 1.f, 1.f, 1.f}, H[4] = {0.f, 0.f, 0.f, 0.f};
#pragma unroll 16
    for (int t = 0; t < 64; ++t) {
      const ushort4 la4 = *(const ushort4*)(LLA + (t0 + t) * 1024 + c);
      const ushort4 vv4 = *(const ushort4*)(LVV + (t0 + t) * 1024 + c);
      lru_step4(la4, vv4, H, A, true);
    }
    *(float4*)(LCH + (long)(seq * 64 + ch) * 2048 + c) = make_float4(A[0], A[1], A[2], A[3]);
    *(float4*)(LCH + (long)(seq * 64 + ch) * 2048 + 1024 + c) = make_float4(H[0], H[1], H[2], H[3]);
  }
}

__device__ __forceinline__ void phase_mix3(const Ctx& cx, const Params& p, int l) {
  const int nblk_lru = (4 * 64 * 256 + 8 * 256) / 256;
  for (int job = BID; job < NGJOB + nblk_lru; job += NBLK) {
    if (job < NGJOB) {
      gla_phase_c(cx, p, l, job);
    } else {
      const int it = (job - NGJOB) * 256 + TID;
      const u16* __restrict__ LLA = (const u16*)(cx.ws + WS_LLA);
      const u16* __restrict__ LVV = (const u16*)(cx.ws + WS_LVV);
      const float* __restrict__ LCH = (const float*)(cx.ws + WS_LCH);
      u16* __restrict__ OL = (u16*)(cx.ws + WS_OL);
      int c, nt;
      long t0;
      float h[4] = {0.f, 0.f, 0.f, 0.f}, dummy[4];
      float* hout = nullptr;
      if (it < 4 * 64 * 256) {
        c = (it & 255) * 4;
        const int ch = (it >> 8) & 63, seq = it >> 14;
        t0 = (long)seq * 4096 + ch * 64;
        nt = 64;
#pragma unroll 8
        for (int q = 0; q < ch; ++q) {
          const float4 Aq = *(const float4*)(LCH + (long)(seq * 64 + q) * 2048 + c);
          const float4 Hq = *(const float4*)(LCH + (long)(seq * 64 + q) * 2048 + 1024 + c);
          h[0] = Aq.x * h[0] + Hq.x; h[1] = Aq.y * h[1] + Hq.y; h[2] = Aq.z * h[2] + Hq.z; h[3] = Aq.w * h[3] + Hq.w;
        }
        if (ch == 63) hout = cx.out + O_LHP + (long)(l * 4 + seq) * 1024 + c;
      } else {
        const int r = it - 4 * 64 * 256;
        c = (r & 255) * 4;
        const int b = r >> 8;
        t0 = NPT + b * 32;
        nt = 32;
        const float4 h0 = *(const float4*)(p.in[3] + (long)(l * 8 + b) * 1024 + c);
        h[0] = h0.x; h[1] = h0.y; h[2] = h0.z; h[3] = h0.w;
        hout = cx.out + O_LHS + (long)(l * 8 + b) * 1024 + c;
      }
#pragma unroll 8
      for (int t = 0; t < nt; ++t) {
        const ushort4 la4 = *(const ushort4*)(LLA + (t0 + t) * 1024 + c);
        const ushort4 vv4 = *(const ushort4*)(LVV + (t0 + t) * 1024 + c);
        lru_step4(la4, vv4, h, dummy, false);
        *(ushort4*)(OL + (t0 + t) * 1024 + c) = pack4(h[0], h[1], h[2], h[3]);
      }
      if (hout) *(float4*)hout = make_float4(h[0], h[1], h[2], h[3]);
    }
  }
}

__device__ __forceinline__ float row8_allsum(float x) {
  DPP_ADD(x, 0xB1);
  DPP_ADD(x, 0x4E);
  DPP_ADD(x, 0x141);
  return x;
}
__device__ __forceinline__ void bf8_to_f(const bf16x8 v, float (&o)[8]) {
#pragma unroll
  for (int j = 0; j < 8; ++j) o[j] = bf2f((u16)v[j]);
}
__device__ __forceinline__ void phase_rwprep(const Ctx& cx, const Params& p, int l, bool shadow = false) {
  const u16* __restrict__ Y = (const u16*)(cx.ws + WS_Y);
  u16* __restrict__ BR = (u16*)(cx.ws + WS_XC);
  u16* __restrict__ BK = (u16*)(cx.ws + WS_LVV);
  u16* __restrict__ BKK = (u16*)(cx.ws + WS_GST);
  u16* __restrict__ BKA = BKK + (long)NTOK * 1024;
  const u16* __restrict__ BA = (const u16*)(cx.ws + WS_RWA);
  u16* __restrict__ BV = (u16*)(cx.ws + WS_RWA);
  u16* __restrict__ REX = (u16*)(cx.ws + WS_LLA);
  const int ts = TID >> 7, c = (TID & 127) * 8;
  float mur[8], muk[8], muv[8], kkc[8], kac[8], rkc[8];
#pragma unroll
  for (int j = 0; j < 8; ++j) {
    mur[j] = p.in[19][l * 3200 + c + j];
    muk[j] = p.in[19][l * 3200 + 1024 + c + j];
    muv[j] = p.in[19][l * 3200 + 2048 + c + j];
    kkc[j] = p.in[24][l * 1024 + c + j];
    kac[j] = p.in[25][l * 1024 + c + j];
    rkc[j] = p.in[26][l * 1024 + c + j];
  }
#pragma unroll 2
  for (int tb = BID * 2; tb < NTOK; tb += NBLK * 2) {
    const int tok = tb + ts;
    int seq, pos, L;
    tok_decode(tok, seq, pos, L);
    const u16* yr = Y + (long)tok * LDY + YRW + c;
    float cr[8], ck[8], cv[8], af[8], pr[8], pk[8], pv[8];
    bf8_to_f(*(const bf16x8*)(yr), cr);
    bf8_to_f(*(const bf16x8*)(yr + 1024), ck);
    bf8_to_f(*(const bf16x8*)(yr + 2048), cv);
    bf8_to_f(*(const bf16x8*)(BA + (long)tok * 1024 + c), af);
    if (pos > 0) {
      bf8_to_f(*(const bf16x8*)(yr - LDY), pr);
      bf8_to_f(*(const bf16x8*)(yr - LDY + 1024), pk);
      bf8_to_f(*(const bf16x8*)(yr - LDY + 2048), pv);
    } else if (seq >= 4) {
      const float* s0 = p.in[6] + (long)(l * 8 + (seq - 4)) * 3200 + c;
#pragma unroll
      for (int j = 0; j < 8; ++j) { pr[j] = s0[j]; pk[j] = s0[1024 + j]; pv[j] = s0[2048 + j]; }
    } else {
#pragma unroll
      for (int j = 0; j < 8; ++j) { pr[j] = 0.f; pk[j] = 0.f; pv[j] = 0.f; }
    }
    float r[8], kp[8], v[8], kkr[8];
    float n2 = 0.f, rk = 0.f;
#pragma unroll
    for (int j = 0; j < 8; ++j) {
      r[j] = cr[j] + (pr[j] - cr[j]) * mur[j];
      const float k = ck[j] + (pk[j] - ck[j]) * muk[j];
      v[j] = cv[j] + (pv[j] - cv[j]) * muv[j];
      kkr[j] = k * kkc[j];
      n2 += kkr[j] * kkr[j];
      kp[j] = k * (1.f + (af[j] - 1.f) * kac[j]);
      rk += r[j] * kp[j] * rkc[j];
    }
    n2 = row8_allsum(n2);
    rk = row8_allsum(rk);
    const float rn = rsqrtf(n2 + 1e-12f);
    bf16x8 o_r, o_k, o_kk, o_ka, o_v, o_e;
#pragma unroll
    for (int j = 0; j < 8; ++j) {
      o_r[j] = (short)f2bf(r[j]);
      o_k[j] = (short)f2bf(kp[j]);
      o_kk[j] = (short)f2bf(kkr[j] * rn);
      o_ka[j] = (short)f2bf(kkr[j] * rn * af[j]);
      o_v[j] = (short)f2bf(v[j]);
      o_e[j] = (short)f2bf(rk * v[j]);
    }
    const long o = (long)tok * 1024 + c;
    *(bf16x8*)(BR + o) = o_r;
    *(bf16x8*)(BK + o) = o_k;
    *(bf16x8*)(BKK + o) = o_kk;
    *(bf16x8*)(BKA + o) = o_ka;
    if (!shadow) *(bf16x8*)(BV + o) = o_v;
    *(bf16x8*)(REX + o) = o_e;
  }
}

__device__ __forceinline__ void inproj2_tile(const Ctx& cx, int mt, int nt, const float* gnw, const float* gnb);
constexpr int RT_T = 16;
typedef float f32x2 __attribute__((ext_vector_type(2)));
__device__ __forceinline__ void phase_rwscan(const Ctx& cx, const Params& p, int l, int l2) {
  const u16* BR = (const u16*)(cx.ws + WS_XC);
  const u16* BK = (const u16*)(cx.ws + WS_LVV);
  const u16* BKK = (const u16*)(cx.ws + WS_GST);
  const u16* BKA = BKK + (long)NTOK * 1024;
  const u16* BV = (const u16*)(cx.ws + WS_RWA);
  const float* RWW = (const float*)(cx.ws + WS_RWW);
  u16* OR = (u16*)(cx.ws + WS_OR);
  float* sR = (float*)smem;
  float* sW = sR + RT_T * 64;
  float* sK = sW + RT_T * 64;
  float* sKK = sK + RT_T * 64;
  float* sKA = sKK + RT_T * 64;
  float* sV = sKA + RT_T * 64;
  float* sY = sV + RT_T * 64;
  const int tid = TID, wave = tid >> 6, lane = tid & 63;
  int* ctl = (int*)(cx.ws + WS_CTL);
  volatile int* s_ctl = (volatile int*)(smem + SMEM_CTL);
  if (tid == 0) {
    const unsigned xcc = (unsigned)__builtin_amdgcn_s_getreg((3 << 11) | 20) & 0xFu;
    const unsigned cu = ((unsigned)__builtin_amdgcn_s_getreg(63492) >> 8) & 0xFFu;
    const int key = l2 * 4096 + xcc * 256 + cu;
    int role;
    if (atomicAdd(ctl + CTL_CLAIM + key, 1) == 0) {
      const int rank = atomicAdd(ctl + CTL_NCU + l2, 1);
      role = (rank < 128) ? 2 : 1;
      __hip_atomic_store(ctl + CTL_ROLE + key, role, __ATOMIC_RELAXED, __HIP_MEMORY_SCOPE_AGENT);
    } else {
      int spins = 0;
      while ((role = __hip_atomic_load(ctl + CTL_ROLE + key, __ATOMIC_RELAXED, __HIP_MEMORY_SCOPE_AGENT)) == 0 && ++spins < (1 << 20)) __builtin_amdgcn_s_sleep(1);
      if (role == 0) role = 1;
    }
    s_ctl[1] = (role == 2) ? 1 : 0;
  }
  __syncthreads();
  const int first = s_ctl[1];
  int stage = first ? 0 : 1;
  for (;;) {
    __syncthreads();
    if (tid == 0) {
      int job = -1, st = stage;
      while (job < 0 && st < 4) {
        if (st == 0 || st == 3) {
          const int j = atomicAdd(ctl + CTL_QP + l2, 1);
          if (j < 256) job = j; else ++st;
        } else if (st == 1) {
          const int j = atomicAdd(ctl + CTL_QS + l2, 1);
          if (j < 512) job = 256 + j; else ++st;
        } else {
          const int total = NMT * 40;
          for (int a = 0; a < 8 && job < 0; ++a) {
            const int x = (BID + a) & 7;
            const int c = atomicAdd(ctl + CTL_QG + l2 * 8 + x, 1);
            const int t = ((c >> 6) * 8 + x) * 64 + (c & 63);
            if (t < total) job = 1024 + t;
          }
          if (job < 0) ++st;
        }
      }
      s_ctl[2] = job;
      s_ctl[3] = st;
    }
    __syncthreads();
    const int job = s_ctl[2];
    stage = s_ctl[3];
    if (job < 0) break;
    if (stage == 0) stage = 1;
    if (job >= 1024) {
      const int t = job - 1024, sn = t / (NMT * 8), r = t % (NMT * 8);
      const int mt = r >> 3, ni = sn * 8 + (r & 7);
      inproj2_tile(cx, mt, ni < 16 ? ni : ni + 8, nullptr, nullptr);
      continue;
    }
    int seq, h, rq, L, t0;
    if (job < 256) { seq = job >> 6; h = (job >> 2) & 15; rq = job & 3; L = 4096; t0 = seq * 4096; }
    else { int j = job - 256; seq = 4 + (j >> 6); h = (j >> 2) & 15; rq = j & 3; L = 32; t0 = NPT + (seq - 4) * 32; }
    const int rloc = wave * 4 + (lane >> 4), row = rq * 16 + rloc, kq = lane & 15;
    float S0, S1, S2, S3;
    if (seq >= 4) {
      const float4 s = *(const float4*)(p.in[5] + ((((long)(l * 8 + (seq - 4)) * 16 + h) * 64 + row) * 64 + kq * 4));
      S0 = s.x; S1 = s.y; S2 = s.z; S3 = s.w;
    } else { S0 = S1 = S2 = S3 = 0.f; }
    ushort4 gr0, gk0, gkk0, gka0, gv0, gr1, gk1, gkk1, gka1, gv1;
    float4 gw0, gw1;
    const int ntiles = L / RT_T;
    const int pf_tt = tid >> 4, pf_c4 = (tid & 15) * 4;
#define RW_LOAD(tile_, Q)                                                                      \
    {                                                                                          \
      const long o = (long)(t0 + (tile_) * RT_T + pf_tt) * 1024 + h * 64 + pf_c4;              \
      gr##Q = *(const ushort4*)(BR + o);                                                       \
      gk##Q = *(const ushort4*)(BK + o);                                                       \
      gkk##Q = *(const ushort4*)(BKK + o);                                                     \
      gka##Q = *(const ushort4*)(BKA + o);                                                     \
      gv##Q = *(const ushort4*)(BV + o);                                                       \
      gw##Q = *(const float4*)(RWW + o);                                                       \
    }
#define RW_STORE(Q)                                                                                              \
    {                                                                                                            \
      const int o = pf_tt * 64 + pf_c4;                                                                          \
      *(float4*)(sR + o) = make_float4(bf2f(gr##Q.x), bf2f(gr##Q.y), bf2f(gr##Q.z), bf2f(gr##Q.w));              \
      *(float4*)(sK + o) = make_float4(bf2f(gk##Q.x), bf2f(gk##Q.y), bf2f(gk##Q.z), bf2f(gk##Q.w));              \
      *(float4*)(sKK + o) = make_float4(bf2f(gkk##Q.x), bf2f(gkk##Q.y), bf2f(gkk##Q.z), bf2f(gkk##Q.w));         \
      *(float4*)(sKA + o) = make_float4(bf2f(gka##Q.x), bf2f(gka##Q.y), bf2f(gka##Q.z), bf2f(gka##Q.w));         \
      *(float4*)(sV + o) = make_float4(bf2f(gv##Q.x), bf2f(gv##Q.y), bf2f(gv##Q.z), bf2f(gv##Q.w));              \
      *(float4*)(sW + o) = gw##Q;                                                                                \
    }
#define RW_LD(tt_, X)                                                 \
      X##w = *(const float4*)(sW + (tt_) * 64 + kq * 4);               \
      X##k = *(const float4*)(sK + (tt_) * 64 + kq * 4);               \
      X##kk = *(const float4*)(sKK + (tt_) * 64 + kq * 4);             \
      X##ka = *(const float4*)(sKA + (tt_) * 64 + kq * 4);             \
      X##r = *(const float4*)(sR + (tt_) * 64 + kq * 4);               \
      X##v = sV[(tt_) * 64 + row];
#define LO2(v4) ((f32x2){(v4).x, (v4).y})
#define HI2(v4) ((f32x2){(v4).z, (v4).w})
#define RW_STEP(tt_, X)                                                                            \
      {                                                                                            \
        f32x2 d = S01 * LO2(X##kk);                                                                \
        d = __builtin_elementwise_fma(S23, HI2(X##kk), d);                                         \
        float sk = d.x + d.y;                                                                      \
        sk = row16_allsum(sk);                                                                     \
        const f32x2 vv2 = (f32x2){X##v, X##v}, nsk2 = (f32x2){-sk, -sk};                           \
        f32x2 t01 = LO2(X##k) * vv2, t23 = HI2(X##k) * vv2;                                        \
        t01 = __builtin_elementwise_fma(LO2(X##ka), nsk2, t01);                                    \
        t23 = __builtin_elementwise_fma(HI2(X##ka), nsk2, t23);                                    \
        S01 = __builtin_elementwise_fma(S01, LO2(X##w), t01);                                      \
        S23 = __builtin_elementwise_fma(S23, HI2(X##w), t23);                                      \
        f32x2 y2 = S01 * LO2(X##r);                                                                \
        y2 = __builtin_elementwise_fma(S23, HI2(X##r), y2);                                        \
        sY[(tt_) * 256 + wave * 64 + lane] = y2.x + y2.y;                                          \
      }                                                                                            \
      __builtin_amdgcn_sched_barrier(0);
#define RW_TILE(tile_, Q)                                                                          \
    {                                                                                              \
      RW_STORE(Q)                                                                                  \
      __syncthreads();                                                                             \
      if ((tile_) + 2 < ntiles) { RW_LOAD((tile_) + 2, Q) }                                        \
      float4 Aw, Ak, Akk, Aka, Ar, Bw, Bk, Bkk, Bka, Br;                                           \
      float Av, Bv;                                                                                \
      RW_LD(0, A)                                                                                  \
      _Pragma("unroll 2") for (int tt = 0; tt < RT_T; tt += 2) {                                   \
        RW_LD(tt + 1, B)                                                                           \
        __builtin_amdgcn_sched_barrier(0);                                                         \
        RW_STEP(tt, A)                                                                             \
        { const int tn = (tt + 2 < RT_T) ? tt + 2 : tt; RW_LD(tn, A) }                             \
        __builtin_amdgcn_sched_barrier(0);                                                         \
        RW_STEP(tt + 1, B)                                                                         \
      }                                                                                            \
      __syncthreads();                                                                             \
      {                                                                                            \
        const int tt = tid >> 4, rr = tid & 15;                                                    \
        const float4 y0 = *(const float4*)(sY + tt * 256 + rr * 16), y1 = *(const float4*)(sY + tt * 256 + rr * 16 + 4);      \
        const float4 y2 = *(const float4*)(sY + tt * 256 + rr * 16 + 8), y3 = *(const float4*)(sY + tt * 256 + rr * 16 + 12); \
        const float ys = ((y0.x + y0.y) + (y0.z + y0.w)) + ((y1.x + y1.y) + (y1.z + y1.w)) + ((y2.x + y2.y) + (y2.z + y2.w)) + ((y3.x + y3.y) + (y3.z + y3.w)); \
        OR[(long)(t0 + (tile_) * RT_T + tt) * 1024 + h * 64 + rq * 16 + rr] = f2bf(ys);             \
      }                                                                                            \
    }
    f32x2 S01, S23;
    S01.x = S0; S01.y = S1; S23.x = S2; S23.y = S3;
    RW_LOAD(0, 0)
    if (ntiles > 1) { RW_LOAD(1, 1) }
    for (int tile = 0; tile < ntiles; tile += 2) {
      RW_TILE(tile, 0)
      if (tile + 1 < ntiles) RW_TILE(tile + 1, 1)
    }
#undef RW_TILE
#undef RW_LD
#undef RW_STEP
#undef LO2
#undef HI2
#undef RW_STORE
#undef RW_LOAD
    const float S0o = S01.x, S1o = S01.y, S2o = S23.x, S3o = S23.y;
    float* so = (seq < 4) ? (cx.out + O_RWP + ((((long)(l * 4 + seq) * 16 + h) * 64 + row) * 64 + kq * 4))
                          : (cx.out + O_RWS + ((((long)(l * 8 + (seq - 4)) * 16 + h) * 64 + row) * 64 + kq * 4));
    *(float4*)so = make_float4(S0o, S1o, S2o, S3o);
    __syncthreads();
  }
}

__device__ __forceinline__ void phase_rwgn(const Ctx& cx, const Params& p, int l) {
  u16* __restrict__ OR = (u16*)(cx.ws + WS_OR);
  const u16* __restrict__ ORr = (const u16*)(cx.ws + WS_OR);
  const u16* __restrict__ REX = (const u16*)(cx.ws + WS_LLA);
  const int c = TID * 4;
  const float4 gw = *(const float4*)(p.in[27] + l * 1024 + c);
  const float4 gb = *(const float4*)(p.in[28] + l * 1024 + c);
#pragma unroll 4
  for (int tok = BID; tok < NTOK; tok += NBLK) {
    const ushort4 yv = *(const ushort4*)(ORr + (long)tok * 1024 + c);
    const ushort4 ev = *(const ushort4*)(REX + (long)tok * 1024 + c);
    const float y0 = bf2f(yv.x), y1 = bf2f(yv.y), y2 = bf2f(yv.z), y3 = bf2f(yv.w);
    float s = y0 + y1 + y2 + y3, ss = y0 * y0 + y1 * y1 + y2 * y2 + y3 * y3;
    s = row16_allsum(s);
    ss = row16_allsum(ss);
    const float mean = s * (1.f / 64.f);
    const float var = fmaxf(ss * (1.f / 64.f) - mean * mean, 0.f);
    const float rs = rsqrtf(var + 64e-5f);
    ushort4 o;
    o.x = f2bf((y0 - mean) * rs * gw.x + gb.x + bf2f(ev.x));
    o.y = f2bf((y1 - mean) * rs * gw.y + gb.y + bf2f(ev.y));
    o.z = f2bf((y2 - mean) * rs * gw.z + gb.z + bf2f(ev.z));
    o.w = f2bf((y3 - mean) * rs * gw.w + gb.w + bf2f(ev.w));
    *(ushort4*)(OR + (long)tok * 1024 + c) = o;
  }
}

__device__ __forceinline__ void inproj2_tile(const Ctx& cx, int mt, int nt, const float* gnw, const float* gnb) {
  const u16* XN = (const u16*)(cx.ws + WS_XN);
  const u16* WT = (const u16*)(cx.ws + WS_WTIN) + (long)6400 * 1024;
  u16* Y = (u16*)(cx.ws + WS_Y);
  f32x4 acc[4][4];
  acc_zero(acc);
  gemm_mainloop(cx, acc, XN + (long)mt * 128 * 1024, 1024, WT + (long)nt * 128 * 1024, 1024, 1024);
  const int grp = nt >> 3;
  if (grp == 2) {
    const u16* OR = (const u16*)(cx.ws + WS_OR);
    const u16* REX = (const u16*)(cx.ws + WS_LLA);
    int e_z = 0; asm volatile("" : "+v"(e_z));
    const int e_tid = TID + e_z, e_wid = e_tid >> 6, e_lane = e_tid & 63, e_wr = e_wid >> 1, e_wc = e_wid & 1, e_fr = e_lane & 15, e_fq = e_lane >> 4;
#pragma unroll
    for (int m = 0; m < 4; ++m) {
      __builtin_amdgcn_sched_barrier(0);
      const int row = mt * 128 + e_wr * 64 + m * 16 + e_fr;
      const int cb = (nt & 7) * 128 + e_wc * 64 + e_fq * 4;
      ushort4 yv[4];
      float s = 0.f, ss = 0.f;
#pragma unroll
      for (int n = 0; n < 4; ++n) {
        yv[n] = *(const ushort4*)(OR + (long)row * 1024 + cb + n * 16);
        const float y0 = bf2f(yv[n].x), y1 = bf2f(yv[n].y), y2 = bf2f(yv[n].z), y3 = bf2f(yv[n].w);
        s += (y0 + y1) + (y2 + y3);
        ss += (y0 * y0 + y1 * y1) + (y2 * y2 + y3 * y3);
      }
      s += __shfl_xor(s, 16); ss += __shfl_xor(ss, 16);
      s += __shfl_xor(s, 32); ss += __shfl_xor(ss, 32);
      const float mean = s * (1.f / 64.f);
      const float rs = rsqrtf(fmaxf(ss * (1.f / 64.f) - mean * mean, 0.f) + 64e-5f);
#pragma unroll
      for (int n = 0; n < 4; ++n) {
        const int col = cb + n * 16;
        const ushort4 ev = *(const ushort4*)(REX + (long)row * 1024 + col);
        const float4 gw = *(const float4*)(gnw + col), gb = *(const float4*)(gnb + col);
        const f32x4 v = acc[m][n];
        const float o0 = (bf2f(yv[n].x) - mean) * rs * gw.x + gb.x + bf2f(ev.x);
        const float o1 = (bf2f(yv[n].y) - mean) * rs * gw.y + gb.y + bf2f(ev.y);
        const float o2 = (bf2f(yv[n].z) - mean) * rs * gw.z + gb.z + bf2f(ev.z);
        const float o3 = (bf2f(yv[n].w) - mean) * rs * gw.w + gb.w + bf2f(ev.w);
        *(ushort4*)(Y + (long)row * LDY + nt * 128 + e_wc * 64 + n * 16 + e_fq * 4) = pack4(o0 * siluf_(v[0]), o1 * siluf_(v[1]), o2 * siluf_(v[2]), o3 * siluf_(v[3]));
      }
    }
  } else if (grp < 3) {
    const u16* O = (const u16*)(cx.ws + (grp == 0 ? WS_OG : WS_OL));
    EPI4_BEGIN
      const int row = mt * 128 + lrow, col = (nt & 7) * 128 + lcol;
      const ushort4 ov = *(const ushort4*)(O + (long)row * 1024 + col);
      *(ushort4*)(Y + (long)row * LDY + nt * 128 + lcol) = pack4(bf2f(ov.x) * siluf_(v[0]), bf2f(ov.y) * siluf_(v[1]), bf2f(ov.z) * siluf_(v[2]), bf2f(ov.w) * siluf_(v[3]));
    EPI4_END
  } else {
    EPI4_BEGIN
      const int row = mt * 128 + lrow;
      *(ushort4*)(Y + (long)row * LDY + nt * 128 + lcol) = pack4(sigmoidf_(v[0]), sigmoidf_(v[1]), sigmoidf_(v[2]), sigmoidf_(v[3]));
    EPI4_END
  }
}
__device__ __forceinline__ void inproj2_tile160_rw(const Ctx& cx, int mt, int nt, const float* gnw, const float* gnb) {
  const u16* XN = (const u16*)(cx.ws + WS_XN);
  const u16* WT = (const u16*)(cx.ws + WS_WTIN) + (long)6400 * 1024;
  u16* Y = (u16*)(cx.ws + WS_Y);
  f32x4 acc[5][4];
  acc_zero5(acc);
  gemm_mainloop3(cx, acc, XN + (long)mt * 160 * 1024, 1024, WT + (long)nt * 128 * 1024, 1024, 1024);
  const u16* OR = (const u16*)(cx.ws + WS_OR);
  const u16* REX = (const u16*)(cx.ws + WS_LLA);
  int e_z = 0; asm volatile("" : "+v"(e_z));
  const int e_tid = TID + e_z, e_wid = e_tid >> 6, e_lane = e_tid & 63, e_wr = e_wid >> 1, e_wc = e_wid & 1, e_fr = e_lane & 15, e_fq = e_lane >> 4;
#pragma unroll
  for (int m = 0; m < 5; ++m) {
    __builtin_amdgcn_sched_barrier(0);
    const int row = mt * 160 + e_wr * 80 + m * 16 + e_fr;
    const int cb = (nt & 7) * 128 + e_wc * 64 + e_fq * 4;
    ushort4 yv[4];
    float s_ = 0.f, ss = 0.f;
#pragma unroll
    for (int n = 0; n < 4; ++n) {
      yv[n] = *(const ushort4*)(OR + (long)row * 1024 + cb + n * 16);
      const float y0 = bf2f(yv[n].x), y1 = bf2f(yv[n].y), y2 = bf2f(yv[n].z), y3 = bf2f(yv[n].w);
      s_ += (y0 + y1) + (y2 + y3);
      ss += (y0 * y0 + y1 * y1) + (y2 * y2 + y3 * y3);
    }
    s_ += __shfl_xor(s_, 16); ss += __shfl_xor(ss, 16);
    s_ += __shfl_xor(s_, 32); ss += __shfl_xor(ss, 32);
    const float mean = s_ * (1.f / 64.f);
    const float rs = rsqrtf(fmaxf(ss * (1.f / 64.f) - mean * mean, 0.f) + 64e-5f);
#pragma unroll
    for (int n = 0; n < 4; ++n) {
      const int col = cb + n * 16;
      const ushort4 ev = *(const ushort4*)(REX + (long)row * 1024 + col);
      const float4 gw = *(const float4*)(gnw + col), gb = *(const float4*)(gnb + col);
      const f32x4 v = acc[m][n];
      const float o0 = (bf2f(yv[n].x) - mean) * rs * gw.x + gb.x + bf2f(ev.x);
      const float o1 = (bf2f(yv[n].y) - mean) * rs * gw.y + gb.y + bf2f(ev.y);
      const float o2 = (bf2f(yv[n].z) - mean) * rs * gw.z + gb.z + bf2f(ev.z);
      const float o3 = (bf2f(yv[n].w) - mean) * rs * gw.w + gb.w + bf2f(ev.w);
      *(ushort4*)(Y + (long)row * LDY + nt * 128 + e_wc * 64 + n * 16 + e_fq * 4) = pack4(o0 * siluf_(v[0]), o1 * siluf_(v[1]), o2 * siluf_(v[2]), o3 * siluf_(v[3]));
    }
  }
}
__device__ __forceinline__ void phase_inproj2(const Ctx& cx, const Params& p, int l) {
  TILE3_LOOP_BEGIN(8)
    inproj2_tile160_rw(cx, mt, nt + 16, p.in[27] + l * 1024, p.in[28] + l * 1024);
  TILE_LOOP_END
}

template <int B>
__device__ __forceinline__ void merge_step(const Ctx& cx, int l, int mt, int nt) {
  const u16* Y = (const u16*)(cx.ws + WS_Y);
  const u16* WTP = (const u16*)(cx.ws + WS_WTP);
  u16* MG = (u16*)(cx.ws + WS_XC);
  float* TF = (float*)(cx.ws + WS_RWW);
  f32x4 acc[5][4];
  acc_zero5(acc);
  gemm_mainloop3(cx, acc, Y + (long)mt * 160 * LDY + B * 1024, LDY, WTP + (long)(l * 4 + B) * 1048576 + (long)nt * 128 * 1024, 1024, 1024);
  EPI5_BEGIN
    const int row = mt * 160 + lrow, col = nt * 128 + lcol;
    const ushort4 g = *(const ushort4*)(Y + (long)row * LDY + 3072 + B * 1024 + col);
    float4 t = make_float4(bf2f(g.x) * v[0], bf2f(g.y) * v[1], bf2f(g.z) * v[2], bf2f(g.w) * v[3]);
    if (B > 0) {
      const float4 o = *(const float4*)(TF + (long)row * 1024 + col);
      t.x += o.x; t.y += o.y; t.z += o.z; t.w += o.w;
    }
    if (B < 2) *(float4*)(TF + (long)row * 1024 + col) = t;
    else *(ushort4*)(MG + (long)row * 1024 + col) = pack4(t.x, t.y, t.z, t.w);
  EPI5_END
}
__device__ __forceinline__ void phase_merge(const Ctx& cx, const Params& p, int l) {
  TILE3_LOOP_BEGIN(8)
    merge_step<0>(cx, l, mt, nt);
    merge_step<1>(cx, l, mt, nt);
    merge_step<2>(cx, l, mt, nt);
  TILE_LOOP_END
}

__device__ __forceinline__ void phase_out(const Ctx& cx, const Params& p, int l) {
  const u16* MG = (const u16*)(cx.ws + WS_XC);
  const u16* WTP = (const u16*)(cx.ws + WS_WTP);
  float* X = (float*)(cx.ws + WS_X);
  TILE3_LOOP_BEGIN(8)
    f32x4 acc[5][4];
    acc_zero5(acc);
    gemm_mainloop3(cx, acc, MG + (long)mt * 160 * 1024, 1024, WTP + (long)(l * 4 + 3) * 1048576 + (long)nt * 128 * 1024, 1024, 1024);
    EPI5_BEGIN
      const int row = mt * 160 + lrow, col = nt * 128 + lcol;
      float4 x = *(const float4*)(X + (long)row * 1024 + col);
      x.x += v[0]; x.y += v[1]; x.z += v[2]; x.w += v[3];
      *(float4*)(X + (long)row * 1024 + col) = x;
    EPI5_END
  TILE_LOOP_END
}


#define HB_CNT(x)  (64 * (x))
#define HB_GEN(x)  (64 * (16 + (x)))
#define HB_CEN(x)  (64 * (32 + (x)))
#define HB_TOP     (64 * 48)
__device__ __forceinline__ unsigned hb_ld(unsigned* p) { return __hip_atomic_load(p, __ATOMIC_RELAXED, __HIP_MEMORY_SCOPE_AGENT); }
__device__ __forceinline__ unsigned hb_xcc() { return (unsigned)__builtin_amdgcn_s_getreg((3 << 11) | 20) & 0xFu; }
__device__ __forceinline__ void hier_barrier(unsigned* bar, unsigned k, volatile unsigned* st) {
  asm volatile("s_waitcnt vmcnt(0)" ::: "memory");
  __syncthreads();
  if (threadIdx.x == 0) {
    const unsigned x = hb_xcc();
    unsigned per = st[0], nx = st[1];
    if (per == 0u) {
      const unsigned G = gridDim.x;
      for (;;) {
        unsigned sum = 0u, cnt = 0u, mine = 0u;
#pragma unroll
        for (unsigned j = 0; j < 16; ++j) { const unsigned c = hb_ld(&bar[HB_CEN(j)]); sum += c; cnt += (c > 0u) ? 1u : 0u; mine = (j == x) ? c : mine; }
        if (sum == G) { per = mine; nx = cnt; break; }
        __builtin_amdgcn_s_sleep(1);
      }
      st[0] = per; st[1] = nx;
    }
    const unsigned old = __hip_atomic_fetch_add(&bar[HB_CNT(x)], 1u, __ATOMIC_RELAXED, __HIP_MEMORY_SCOPE_AGENT);
    if (old + 1u == per * k) {
      __builtin_amdgcn_fence(__ATOMIC_RELEASE, "agent");
      asm volatile("s_waitcnt vmcnt(0)" ::: "memory");
      const unsigned ot = __hip_atomic_fetch_add(&bar[HB_TOP], 1u, __ATOMIC_RELAXED, __HIP_MEMORY_SCOPE_AGENT);
      if (ot + 1u == nx * k) {
#pragma unroll
        for (unsigned j = 0; j < 16; ++j) __hip_atomic_store(&bar[HB_GEN(j)], k, __ATOMIC_RELAXED, __HIP_MEMORY_SCOPE_AGENT);
      }
    }
    while (hb_ld(&bar[HB_GEN(x)]) < k) __builtin_amdgcn_s_sleep(1);
    __builtin_amdgcn_fence(__ATOMIC_ACQUIRE, "agent");
    asm volatile("s_waitcnt vmcnt(0)" ::: "memory");
  }
  __syncthreads();
}

constexpr int PH_PER_LAYER = 11;
constexpr int N_PHASES = 1 + 4 * PH_PER_LAYER + 1;

__global__ void __launch_bounds__(256, 2) fwd_kernel(Params p) {
  cg::grid_group grid = cg::this_grid();
  volatile unsigned* hb_st = (volatile unsigned*)(smem + SMEM_CTL + 32);
  if (threadIdx.x == 0) { hb_st[0] = 0u; hb_st[1] = 0u; }
  __syncthreads();
  unsigned hb_k = 0u;
#pragma unroll 1
  for (int ph = p.ph0; ph < p.ph1; ++ph) {
    int zv = 0, zs = 0;
    asm volatile("" : "+v"(zv));
    asm volatile("" : "+s"(zs));
    Ctx cx;
    cx.tid = threadIdx.x + zv;
    cx.bid = blockIdx.x + zs;
    cx.nb = gridDim.x + zs;
    cx.ws = p.ws + zs;
    cx.out = p.out + zs;
    if (ph == 0) phase_convw(cx, p);
    else if (ph == N_PHASES - 1) phase_norm(cx, p, 4);
    else {
      const int l = (ph - 1) / PH_PER_LAYER, s = (ph - 1) % PH_PER_LAYER;
      switch (s) {
        case 0: phase_norm(cx, p, l); break;
        case 1: phase_inproj1(cx, p); if (PROBE_DUP & 1) { grid.sync(); phase_inproj1(cx, p); } break;
        case 2: phase_prep(cx, p, l); if (PROBE_DUP & 16) { grid.sync(); phase_prep(cx, p, l); } break;
        case 3: phase_mix1(cx, p, l); if (PROBE_DUP & 4) { grid.sync(); phase_mix1(cx, p, l); } break;
        case 4: if (PROBE_DUP & 64) { phase_mix2(cx, p, l, true); grid.sync(); } phase_mix2(cx, p, l); break;
        case 5: phase_mix3(cx, p, l); if (PROBE_DUP & 4) { grid.sync(); phase_mix3(cx, p, l); } break;
        case 6: if (PROBE_DUP & 128) { phase_rwprep(cx, p, l, true); grid.sync(); } phase_rwprep(cx, p, l); break;
        case 7: phase_rwscan(cx, p, l, l * 2); if (PROBE_DUP & 2) { grid.sync(); phase_rwscan(cx, p, l, l * 2 + 1); } break;
        case 8: phase_inproj2(cx, p, l); break;
        case 9: phase_merge(cx, p, l); break;
        default: phase_out(cx, p, l); break;
      }
    }
    if (ph + 1 < p.ph1) {
      if (ph == p.ph0) {
        grid.sync();
        if (threadIdx.x == 0) (void)__hip_atomic_fetch_add((unsigned*)(p.ws + WS_BAR) + HB_CEN(hb_xcc()), 1u, __ATOMIC_RELAXED, __HIP_MEMORY_SCOPE_AGENT);
      } else hier_barrier((unsigned*)(p.ws + WS_BAR), ++hb_k, hb_st);
    }
  }
}

extern "C" void kernel_launch(void* const* d_in, const int* in_sizes, int n_in, void* d_out, int out_size, void* d_ws, size_t ws_size,
                              hipStream_t stream) {
  static int grid_blocks = 0;
  if (!grid_blocks) {
    int dev = 0, cus = 0, per_cu = 0;
    hipGetDevice(&dev);
    hipDeviceGetAttribute(&cus, hipDeviceAttributeMultiprocessorCount, dev);
    (void)hipFuncSetAttribute((const void*)fwd_kernel, hipFuncAttributeMaxDynamicSharedMemorySize, SMEM_BYTES);
    hipOccupancyMaxActiveBlocksPerMultiprocessor(&per_cu, (const void*)fwd_kernel, 256, SMEM_BYTES);
    if (per_cu < 1) per_cu = 1;
    if (per_cu > 2) per_cu = 2;
    grid_blocks = cus * per_cu;
    if (ws_size < WS_END) fprintf(stderr, "workspace too small: %zu < %zu\n", ws_size, (size_t)WS_END);
  }
  if (n_in < 34 || ws_size < WS_END) return;
  Params p{};
  for (int i = 0; i < 34; ++i) p.in[i] = (const float*)d_in[i];
  p.out = (float*)d_out;
  p.ws = (unsigned char*)d_ws;
#if MULTI_LAUNCH
  for (int ph = 0; ph < N_PHASES; ++ph) {
    p.ph0 = ph; p.ph1 = ph + 1;
    hipLaunchKernelGGL(fwd_kernel, dim3(grid_blocks), dim3(256), SMEM_BYTES, stream, p);
  }
#else
  p.ph0 = 0; p.ph1 = N_PHASES;
  void* args[] = {&p};
  hipError_t e = hipLaunchCooperativeKernel((const void*)fwd_kernel, dim3(grid_blocks), dim3(256), args, SMEM_BYTES, stream);
  if (e != hipSuccess) fprintf(stderr, "cooperative launch failed: %s (grid %d)\n", hipGetErrorString(e), grid_blocks);
#endif
}
```

```cpp
#include <hip/hip_runtime.h>
#include <hip/hip_cooperative_groups.h>
#include <cstdio>
namespace cg = cooperative_groups;

typedef unsigned short u16;
typedef __attribute__((ext_vector_type(8))) short bf16x8;
typedef __attribute__((ext_vector_type(4))) float f32x4;

#ifndef PROBE_DUP
#define PROBE_DUP 0
#endif
#ifndef MULTI_LAUNCH
#define MULTI_LAUNCH 0
#endif

constexpr int NTOK = 16640;
constexpr int NPT = 16384;
constexpr int DM = 1024;
constexpr int DIN = 12432;
constexpr int LDY = 6400;
constexpr int YQ = 0, YK = 512, YV = 1024, YGD = 2048, YXL = 2176, YRW = 3200;
constexpr int NMT = 130;
constexpr int NGJOB = 1056;

constexpr long O_YP = 0, O_YS = 16777216, O_GLAP = 17039360, O_LHP = 19136512, O_LCP = 19152896,
               O_RWP = 19202048, O_RSP = 20250624, O_GLAS = 20301824, O_LHS = 24496128, O_LCS = 24528896,
               O_RWS = 24627200, O_RSS = 26724352;

constexpr size_t al256(size_t x) { return (x + 255) & ~(size_t)255; }
constexpr size_t WS_X = 4096;
constexpr size_t WS_XN = al256(WS_X + (size_t)NTOK * DM * 4);
constexpr size_t WS_Y = al256(WS_XN + (size_t)NTOK * DM * 2);
constexpr size_t WS_WTIN = al256(WS_Y + (size_t)NTOK * LDY * 2 + 65536);
constexpr size_t WS_WTP = al256(WS_WTIN + (size_t)12544 * 1024 * 2);
constexpr size_t WS_WTLRU = al256(WS_WTP + (size_t)16 * 1024 * 1024 * 2);
constexpr size_t WS_WTRW = al256(WS_WTLRU + (size_t)4 * 2 * 8 * 16384 * 2);
constexpr size_t WS_OG = al256(WS_WTRW + (size_t)4 * 2 * 65536 * 2);
constexpr size_t WS_OL = al256(WS_OG + (size_t)NTOK * DM * 2);
constexpr size_t WS_OR = al256(WS_OL + (size_t)NTOK * DM * 2);
constexpr size_t WS_XC = al256(WS_OR + (size_t)NTOK * DM * 2);
constexpr size_t WS_GST = al256(WS_XC + (size_t)NTOK * DM * 2);
constexpr size_t WS_GDEC = al256(WS_GST + (size_t)NGJOB * 32768 * 2);
constexpr size_t WS_LLA = al256(WS_GDEC + (size_t)NGJOB * 128 * 4);
constexpr size_t WS_LVV = al256(WS_LLA + (size_t)NTOK * DM * 2);
constexpr size_t WS_LCH = al256(WS_LVV + (size_t)NTOK * DM * 2);
constexpr size_t WS_RWW = al256(WS_LCH + (size_t)256 * 1024 * 2 * 4);
constexpr size_t WS_RWA = al256(WS_RWW + (size_t)NTOK * DM * 4);
constexpr size_t WS_RT = al256(WS_RWA + (size_t)NTOK * DM * 2);
constexpr size_t WS_CSP = al256(WS_RT + (size_t)NTOK * 128 * 2);
constexpr size_t WS_CTL = al256(WS_CSP + 4096 * 4);
constexpr int CTL_CLAIM = 0;
constexpr int CTL_QP = 8 * 4096;
constexpr int CTL_QS = CTL_QP + 8;
constexpr int CTL_QG = CTL_QS + 8;
constexpr int CTL_ROLE = CTL_QG + 64;
constexpr int CTL_NCU = CTL_ROLE + 8 * 4096;
constexpr int CTL_WORDS = CTL_NCU + 8;
constexpr size_t WS_BAR = al256(WS_CTL + (size_t)CTL_WORDS * 4);
constexpr int HB_WORDS = 64 * 50;
constexpr size_t WS_END = al256(WS_BAR + (size_t)HB_WORDS * 4);

struct Params {
  const float* in[34];
  float* out;
  unsigned char* ws;
  int ph0, ph1;
};

struct Ctx { int tid, bid, nb; unsigned char* ws; float* out; };
#define TID (cx.tid)
#define BID (cx.bid)
#define NBLK (cx.nb)
extern __shared__ __attribute__((aligned(16))) unsigned char smem[];
constexpr int SMEM_CTL = 72 * 1024;
constexpr int SMEM_BYTES = SMEM_CTL + 64;

__device__ __forceinline__ u16 f2bf(float f) {
  unsigned u = __float_as_uint(f);
  u += 0x7fffu + ((u >> 16) & 1u);
  return (u16)(u >> 16);
}
__device__ __forceinline__ float bf2f(u16 h) { return __uint_as_float(((unsigned)h) << 16); }
__device__ __forceinline__ float sigmoidf_(float x) { return 1.f / (1.f + __expf(-x)); }
__device__ __forceinline__ float siluf_(float x) { return x / (1.f + __expf(-x)); }
__device__ __forceinline__ float logsigmoidf_(float x) { return fminf(x, 0.f) - __logf(1.f + __expf(-fabsf(x))); }

__device__ __forceinline__ float dppf(float x, const int ctrl) {
  return x;
}
#define DPP_ADD(x, ctrl) x += __int_as_float(__builtin_amdgcn_update_dpp(0, __float_as_int(x), ctrl, 0xF, 0xF, true))
__device__ __forceinline__ float row16_allsum(float x) {
  DPP_ADD(x, 0xB1);
  DPP_ADD(x, 0x4E);
  DPP_ADD(x, 0x141);
  DPP_ADD(x, 0x140);
  return x;
}
__device__ __forceinline__ float wave_allsum(float x) {
#pragma unroll
  for (int o = 32; o >= 1; o >>= 1) x += __shfl_xor(x, o);
  return x;
}

__device__ __forceinline__ void gemm_mainloop(const Ctx& cx, f32x4 (&acc)[4][4], const u16* Ag, int lda, const u16* Bg, int ldb, int K) {
  const int tid = TID, wid = tid >> 6, lane = tid & 63, wr = wid >> 1, wc = wid & 1, fr = lane & 15, fq = lane >> 4;
  const int nk = K >> 6;
  const int lr0 = tid >> 3, lc = ((tid & 7) ^ ((tid >> 4) & 7)) * 8;
  const u16* ga = Ag + (long)lr0 * lda + lc;
  const u16* gb = Bg + (long)lr0 * ldb + lc;
  const int swz = (fr >> 1) & 7;
#define G_ISSUE(kt_, buf_)                                                                                                   \
  {                                                                                                                          \
    unsigned char* d_ = smem + (buf_) * 32768 + tid * 16;                                                                    \
    _Pragma("unroll") for (int i = 0; i < 4; ++i) {                                                                          \
      __builtin_amdgcn_global_load_lds((const unsigned*)(ga + (long)(i * 32) * lda + (kt_) * 64),                            \
                                       (__attribute__((address_space(3))) unsigned*)(d_ + i * 4096), 16, 0, 0);              \
      __builtin_amdgcn_global_load_lds((const unsigned*)(gb + (long)(i * 32) * ldb + (kt_) * 64),                            \
                                       (__attribute__((address_space(3))) unsigned*)(d_ + 16384 + i * 4096), 16, 0, 0);      \
    }                                                                                                                        \
  }
  G_ISSUE(0, 0)
  asm volatile("s_waitcnt vmcnt(0)" ::: "memory");
  __syncthreads();
  for (int kt = 0; kt < nk; ++kt) {
    if (kt + 1 < nk) G_ISSUE(kt + 1, (kt + 1) & 1)
    const unsigned char* SA = smem + (kt & 1) * 32768;
    const unsigned char* SB = SA + 16384;
#pragma unroll
    for (int ks = 0; ks < 2; ++ks) {
      const int co = ((ks * 4 + fq) ^ swz) * 16;
      bf16x8 At[4], Bt[4];
#pragma unroll
      for (int m = 0; m < 4; ++m) At[m] = *(const bf16x8*)(SA + (wr * 64 + m * 16 + fr) * 128 + co);
#pragma unroll
      for (int n = 0; n < 4; ++n) Bt[n] = *(const bf16x8*)(SB + (wc * 64 + n * 16 + fr) * 128 + co);
      __builtin_amdgcn_s_setprio(1);
#pragma unroll
      for (int m = 0; m < 4; ++m)
#pragma unroll
        for (int n = 0; n < 4; ++n) acc[m][n] = __builtin_amdgcn_mfma_f32_16x16x32_bf16(Bt[n], At[m], acc[m][n], 0, 0, 0);
      __builtin_amdgcn_s_setprio(0);
    }
    asm volatile("s_waitcnt vmcnt(0)" ::: "memory");
    __syncthreads();
  }
#undef G_ISSUE
}
__device__ __forceinline__ void gemm_mainloop3(const Ctx& cx, f32x4 (&acc)[5][4], const u16* Ag, int lda, const u16* Bg, int ldb, int K) {
  const int tid = TID, wid = tid >> 6, lane = tid & 63, wr = wid >> 1, wc = wid & 1, fr = lane & 15, fq = lane >> 4;
  const int nk = K >> 6;
  const int lr0 = tid >> 3, lc = ((tid & 7) ^ ((tid >> 4) & 7)) * 8;
  const u16* ga = Ag + (long)lr0 * lda + lc;
  const u16* gb = Bg + (long)lr0 * ldb + lc;
  const int swz = (fr >> 1) & 7;
#define G3_ISSUE(kt_, buf_)                                                                                                  \
  {                                                                                                                          \
    unsigned char* d_ = smem + (buf_) * 36864 + tid * 16;                                                                    \
    _Pragma("unroll") for (int i = 0; i < 5; ++i)                                                                            \
      __builtin_amdgcn_global_load_lds((const unsigned*)(ga + (long)(i * 32) * lda + (kt_) * 64),                            \
                                       (__attribute__((address_space(3))) unsigned*)(d_ + i * 4096), 16, 0, 0);              \
    _Pragma("unroll") for (int i = 0; i < 4; ++i)                                                                            \
      __builtin_amdgcn_global_load_lds((const unsigned*)(gb + (long)(i * 32) * ldb + (kt_) * 64),                            \
                                       (__attribute__((address_space(3))) unsigned*)(d_ + 20480 + i * 4096), 16, 0, 0);      \
  }
  G3_ISSUE(0, 0)
  asm volatile("s_waitcnt vmcnt(0)" ::: "memory");
  __syncthreads();
  for (int kt = 0; kt < nk; ++kt) {
    if (kt + 1 < nk) G3_ISSUE(kt + 1, (kt + 1) & 1)
    const unsigned char* SA = smem + (kt & 1) * 36864;
    const unsigned char* SB = SA + 20480;
#pragma unroll
    for (int ks = 0; ks < 2; ++ks) {
      const int co = ((ks * 4 + fq) ^ swz) * 16;
      bf16x8 At[5], Bt[4];
#pragma unroll
      for (int m = 0; m < 5; ++m) At[m] = *(const bf16x8*)(SA + (wr * 80 + m * 16 + fr) * 128 + co);
#pragma unroll
      for (int n = 0; n < 4; ++n) Bt[n] = *(const bf16x8*)(SB + (wc * 64 + n * 16 + fr) * 128 + co);
      __builtin_amdgcn_s_setprio(1);
#pragma unroll
      for (int m = 0; m < 5; ++m)
#pragma unroll
        for (int n = 0; n < 4; ++n) acc[m][n] = __builtin_amdgcn_mfma_f32_16x16x32_bf16(Bt[n], At[m], acc[m][n], 0, 0, 0);
      __builtin_amdgcn_s_setprio(0);
    }
    asm volatile("s_waitcnt vmcnt(0)" ::: "memory");
    __syncthreads();
  }
#undef G3_ISSUE
}
__device__ __forceinline__ void acc_zero5(f32x4 (&acc)[5][4]) {
#pragma unroll
  for (int m = 0; m < 5; ++m)
#pragma unroll
    for (int n = 0; n < 4; ++n) acc[m][n] = (f32x4){0.f, 0.f, 0.f, 0.f};
}
#define EPI5_BEGIN                                                                                          \
  {                                                                                                         \
    int e_z = 0; asm volatile("" : "+v"(e_z));                                                              \
    const int e_tid = TID + e_z, e_wid = e_tid >> 6, e_lane = e_tid & 63, e_wr = e_wid >> 1, e_wc = e_wid & 1, \
              e_fr = e_lane & 15, e_fq = e_lane >> 4;                                                       \
    _Pragma("unroll") for (int m = 0; m < 5; ++m) { __builtin_amdgcn_sched_barrier(0);                      \
      _Pragma("unroll") for (int n = 0; n < 4; ++n) {                                                       \
      const int lrow = e_wr * 80 + m * 16 + e_fr;                                                           \
      const int lcol = e_wc * 64 + n * 16 + e_fq * 4;                                                       \
      const f32x4 v = acc[m][n];
#define EPI5_END \
  }              \
  }              \
  }
constexpr int NMT3 = 104;
__device__ __forceinline__ void acc_zero(f32x4 (&acc)[4][4]) {
#pragma unroll
  for (int m = 0; m < 4; ++m)
#pragma unroll
    for (int n = 0; n < 4; ++n) acc[m][n] = (f32x4){0.f, 0.f, 0.f, 0.f};
}
#define EPI4_BEGIN                                                                                          \
  {                                                                                                         \
    int e_z = 0; asm volatile("" : "+v"(e_z));                                                              \
    const int e_tid = TID + e_z, e_wid = e_tid >> 6, e_lane = e_tid & 63, e_wr = e_wid >> 1, e_wc = e_wid & 1, \
              e_fr = e_lane & 15, e_fq = e_lane >> 4;                                                       \
    _Pragma("unroll") for (int m = 0; m < 4; ++m) { __builtin_amdgcn_sched_barrier(0);                      \
      _Pragma("unroll") for (int n = 0; n < 4; ++n) {                                                       \
      const int lrow = e_wr * 64 + m * 16 + e_fr;                                                           \
      const int lcol = e_wc * 64 + n * 16 + e_fq * 4;                                                       \
      const f32x4 v = acc[m][n];
#define EPI4_END \
  }              \
  }              \
  }
__device__ __forceinline__ ushort4 pack4(float a, float b, float c, float d) {
  ushort4 o; o.x = f2bf(a); o.y = f2bf(b); o.z = f2bf(c); o.w = f2bf(d); return o;
}

__device__ __forceinline__ void tok_decode(int tok, int& seq, int& pos, int& L) {
  if (tok < NPT) { seq = tok >> 12; pos = tok & 4095; L = 4096; }
  else { int t = tok - NPT; seq = 4 + (t >> 5); pos = t & 31; L = 32; }
}

__device__ __forceinline__ void tconv(const Ctx& cx, const float* __restrict__ src, int K, int N, u16* __restrict__ dst) {
  const int items = N * (K >> 3);
  for (int it = BID * 256 + TID; it < items; it += NBLK * 256) {
    int n = it % N, k8 = it / N;
    bf16x8 v;
#pragma unroll
    for (int j = 0; j < 8; ++j) v[j] = (short)f2bf(src[(long)(k8 * 8 + j) * N + n]);
    *(bf16x8*)(dst + (long)n * K + k8 * 8) = v;
  }
}

__device__ __forceinline__ void phase_convw(const Ctx& cx, const Params& p) {
  u16* WTP = (u16*)(cx.ws + WS_WTP);
  u16* WTLRU = (u16*)(cx.ws + WS_WTLRU);
  u16* WTRW = (u16*)(cx.ws + WS_WTRW);
  for (int it = BID * 256 + TID; it < CTL_WORDS; it += NBLK * 256) ((int*)(cx.ws + WS_CTL))[it] = 0;
  for (int it = BID * 256 + TID; it < HB_WORDS; it += NBLK * 256) ((unsigned*)(cx.ws + WS_BAR))[it] = 0u;
  for (int it = BID * 256 + TID; it < 4096; it += NBLK * 256) {
    const float nl = -p.in[18][it];
    ((float*)(cx.ws + WS_CSP))[it] = -8.f * (fmaxf(nl, 0.f) + log1pf(__expf(-fabsf(nl))));
  }
  for (int l = 0; l < 4; ++l) {
    tconv(cx, p.in[29] + (long)l * 1048576, 1024, 1024, WTP + (long)(l * 4 + 0) * 1048576);
    tconv(cx, p.in[30] + (long)l * 1048576, 1024, 1024, WTP + (long)(l * 4 + 1) * 1048576);
    tconv(cx, p.in[31] + (long)l * 1048576, 1024, 1024, WTP + (long)(l * 4 + 2) * 1048576);
    tconv(cx, p.in[32] + (long)l * 1048576, 1024, 1024, WTP + (long)(l * 4 + 3) * 1048576);
    for (int n = 0; n < 8; ++n) {
      tconv(cx, p.in[14] + (long)(l * 8 + n) * 16384, 128, 128, WTLRU + (long)((l * 2 + 0) * 8 + n) * 16384);
      tconv(cx, p.in[16] + (long)(l * 8 + n) * 16384, 128, 128, WTLRU + (long)((l * 2 + 1) * 8 + n) * 16384);
    }
    tconv(cx, p.in[21] + (long)l * 65536, 64, 1024, WTRW + (long)(l * 2 + 0) * 65536);
    tconv(cx, p.in[23] + (long)l * 65536, 64, 1024, WTRW + (long)(l * 2 + 1) * 65536);
  }
}

__device__ __forceinline__ void phase_norm(const Ctx& cx, const Params& p, int l) {
  float* X = (float*)(cx.ws + WS_X);
  u16* XN = (u16*)(cx.ws + WS_XN);
  const int lane = TID & 63;
  const float* g = (l < 4) ? (p.in[7] + l * 1024) : p.in[33];
  for (int row = BID * 4 + (TID >> 6); row < NTOK; row += NBLK * 4) {
    const float* src = (l == 0) ? (row < NPT ? p.in[0] + (long)row * 1024 : p.in[1] + (long)(row - NPT) * 1024) : X + (long)row * 1024;
    float4 v[4];
    float ss = 0.f;
#pragma unroll
    for (int i = 0; i < 4; ++i) {
      v[i] = ((const float4*)src)[lane + 64 * i];
      ss += v[i].x * v[i].x + v[i].y * v[i].y + v[i].z * v[i].z + v[i].w * v[i].w;
    }
    ss = wave_allsum(ss);
    const float r = rsqrtf(ss * (1.f / 1024.f) + 1e-6f);
#pragma unroll
    for (int i = 0; i < 4; ++i) {
      const int c = (lane + 64 * i) * 4;
      float4 gg = *(const float4*)(g + c);
      float4 o;
      o.x = v[i].x * r * gg.x; o.y = v[i].y * r * gg.y; o.z = v[i].z * r * gg.z; o.w = v[i].w * r * gg.w;
      if (l == 0) ((float4*)(X + (long)row * 1024))[lane + 64 * i] = v[i];
      if (l < 4) {
        ushort4 ob;
        ob.x = f2bf(o.x); ob.y = f2bf(o.y); ob.z = f2bf(o.z); ob.w = f2bf(o.w);
        *(ushort4*)(XN + (long)row * 1024 + c) = ob;
      } else {
        float* dst = (row < NPT) ? (cx.out + O_YP + (long)row * 1024) : (cx.out + O_YS + (long)(row - NPT) * 1024);
        *(float4*)(dst + c) = o;
      }
    }
  }
  if (l < 4) {
    const float* W = p.in[8] + (long)l * 1024 * DIN;
    u16* WT = (u16*)(cx.ws + WS_WTIN);
    const int items = 12544 * 128;
    for (int it = BID * 256 + TID; it < items; it += NBLK * 256) {
      int n = it % 12544, k8 = it / 12544;
      int sc;
      if (n < 6400) {
        if (n < 2064) sc = n;
        else if (n < 2176) sc = -1;
        else if (n < 3200) sc = 3088 + (n - 2176);
        else sc = 5136 + (n - 3200);
      } else {
        int q = n - 6400;
        if (q < 1024) sc = 2064 + q;
        else if (q < 2048) sc = 4112 + (q - 1024);
        else if (q < 3072) sc = 8336 + (q - 2048);
        else sc = 9360 + (q - 3072);
      }
      bf16x8 v;
#pragma unroll
      for (int j = 0; j < 8; ++j) v[j] = (sc >= 0) ? (short)f2bf(W[(long)(k8 * 8 + j) * DIN + sc]) : (short)0;
      *(bf16x8*)(WT + (long)n * 1024 + k8 * 8) = v;
    }
  }
}

#define TILE_LOOP_BEGIN(NT_)                                                                \
  {                                                                                         \
    const int tl_total = NMT * (NT_), tl_per = NBLK >> 3, tl_x = BID & 7, tl_l = BID >> 3;  \
    const int tl_full = (NT_) >> 3;                                                         \
    for (int tl_it = 0;; ++tl_it) {                                                         \
      const int tl_base = (tl_it * 8 + tl_x) * tl_per;                                      \
      if (tl_it * 8 * tl_per >= tl_total) break;                                            \
      const int t = tl_base + tl_l;                                                         \
      if (t >= tl_total) continue;                                                          \
      int mt, nt;                                                                           \
      if (t < tl_full * (NMT * 8)) { const int sn = t / (NMT * 8), r = t % (NMT * 8); mt = r >> 3; nt = sn * 8 + (r & 7); } \
      else { const int r = t - tl_full * (NMT * 8), wn = (NT_) - tl_full * 8; mt = r / wn; nt = tl_full * 8 + r % wn; }
#define TILE3_LOOP_BEGIN(NT_)                                                                \
  {                                                                                         \
    const int tl_total = NMT3 * (NT_), tl_per = NBLK >> 3, tl_x = BID & 7, tl_l = BID >> 3;  \
    const int tl_full = (NT_) >> 3;                                                         \
    for (int tl_it = 0;; ++tl_it) {                                                         \
      const int tl_base = (tl_it * 8 + tl_x) * tl_per;                                      \
      if (tl_it * 8 * tl_per >= tl_total) break;                                            \
      const int t = tl_base + tl_l;                                                         \
      if (t >= tl_total) continue;                                                          \
      int mt, nt;                                                                           \
      if (t < tl_full * (NMT3 * 8)) { const int sn = t / (NMT3 * 8), r = t % (NMT3 * 8); mt = r >> 3; nt = sn * 8 + (r & 7); } \
      else { const int r = t - tl_full * (NMT3 * 8), wn = (NT_) - tl_full * 8; mt = r / wn; nt = tl_full * 8 + r % wn; }
#define TILE_LOOP_END \
    }                 \
  }

__device__ __forceinline__ void phase_inproj1(const Ctx& cx, const Params& p) {
  const u16* XN = (const u16*)(cx.ws + WS_XN);
  const u16* WT = (const u16*)(cx.ws + WS_WTIN);
  u16* Y = (u16*)(cx.ws + WS_Y);
  TILE_LOOP_BEGIN(50)
    f32x4 acc[4][4];
    acc_zero(acc);
    gemm_mainloop(cx, acc, XN + (long)mt * 128 * 1024, 1024, WT + (long)nt * 128 * 1024, 1024, 1024);
    EPI4_BEGIN
      *(ushort4*)(Y + (long)(mt * 128 + lrow) * LDY + nt * 128 + lcol) = pack4(v[0], v[1], v[2], v[3]);
    EPI4_END
  TILE_LOOP_END
}

__device__ __forceinline__ void phase_prep(const Ctx& cx, const Params& p, int l) {
  const u16* __restrict__ Y = (const u16*)(cx.ws + WS_Y);
  u16* __restrict__ XC = (u16*)(cx.ws + WS_XC);
  u16* __restrict__ RT = (u16*)(cx.ws + WS_RT);
  const int gtid = BID * 256 + TID, gstr = NBLK * 256;
  const float* cw = p.in[12] + l * 4096;
  const float* cb = p.in[13] + l * 1024;
#pragma unroll 2
  for (int it = gtid; it < NTOK * 128; it += gstr) {
    const int tok = it >> 7, c = (it & 127) * 8;
    int seq, pos, L;
    tok_decode(tok, seq, pos, L);
    float a[8], cur[8];
    {
      const float4 b0 = *(const float4*)(cb + c), b1 = *(const float4*)(cb + c + 4);
      a[0] = b0.x; a[1] = b0.y; a[2] = b0.z; a[3] = b0.w; a[4] = b1.x; a[5] = b1.y; a[6] = b1.z; a[7] = b1.w;
    }
#pragma unroll
    for (int t = 0; t < 4; ++t) {
      const int pp = pos - 3 + t;
      float x[8];
      if (pp >= 0) {
        const bf16x8 xv = *(const bf16x8*)(Y + (long)(tok - 3 + t) * LDY + YXL + c);
#pragma unroll
        for (int j = 0; j < 8; ++j) x[j] = bf2f((u16)xv[j]);
      } else if (seq >= 4) {
        const float* s_ = p.in[4] + ((long)((l * 8 + (seq - 4)) * 3 + (pos + t))) * 1024 + c;
#pragma unroll
        for (int j = 0; j < 8; ++j) x[j] = s_[j];
      } else {
#pragma unroll
        for (int j = 0; j < 8; ++j) x[j] = 0.f;
      }
      const float4 w0 = *(const float4*)(cw + t * 1024 + c), w1 = *(const float4*)(cw + t * 1024 + c + 4);
      a[0] += w0.x * x[0]; a[1] += w0.y * x[1]; a[2] += w0.z * x[2]; a[3] += w0.w * x[3];
      a[4] += w1.x * x[4]; a[5] += w1.y * x[5]; a[6] += w1.z * x[6]; a[7] += w1.w * x[7];
      if (t == 3) {
#pragma unroll
        for (int j = 0; j < 8; ++j) cur[j] = x[j];
      }
    }
    bf16x8 o;
#pragma unroll
    for (int j = 0; j < 8; ++j) o[j] = (short)f2bf(a[j]);
    *(bf16x8*)(XC + (long)tok * 1024 + c) = o;
    if (pos >= L - 3) {
      const int jj = pos - (L - 3);
      float* dst = (seq < 4) ? (cx.out + O_LCP + ((long)((l * 4 + seq) * 3 + jj)) * 1024 + c)
                             : (cx.out + O_LCS + ((long)((l * 8 + (seq - 4)) * 3 + jj)) * 1024 + c);
      *(float4*)dst = make_float4(cur[0], cur[1], cur[2], cur[3]);
      *(float4*)(dst + 4) = make_float4(cur[4], cur[5], cur[6], cur[7]);
    }
  }
  const float* mu = p.in[19] + l * 3200;
#pragma unroll 4
  for (int it = gtid; it < NTOK * 128; it += gstr) {
    const int tok = it >> 7, c = it & 127;
    int seq, pos, L;
    tok_decode(tok, seq, pos, L);
    const float cur = bf2f(Y[(long)tok * LDY + YRW + 3072 + c]);
    float prev;
    if (pos > 0) prev = bf2f(Y[(long)(tok - 1) * LDY + YRW + 3072 + c]);
    else if (seq >= 4) prev = p.in[6][(long)(l * 8 + (seq - 4)) * 3200 + 3072 + c];
    else prev = 0.f;
    const float xs = cur + (prev - cur) * mu[3072 + c];
    RT[(long)tok * 128 + c] = f2bf(c < 64 ? tanhf(xs) : xs);
  }
  for (int it = gtid; it < 12 * 3200; it += gstr) {
    const int seq = it / 3200, c = it % 3200;
    const int last = (seq < 4) ? (seq * 4096 + 4095) : (NPT + (seq - 4) * 32 + 31);
    const float v = bf2f(Y[(long)last * LDY + YRW + c]);
    if (seq < 4) cx.out[O_RSP + (long)(l * 4 + seq) * 3200 + c] = v;
    else cx.out[O_RSS + (long)(l * 8 + (seq - 4)) * 3200 + c] = v;
  }
}

__device__ __forceinline__ void gla_job_decode(int job, int& seq, int& h, int& tok0, int& valid) {
  if (job < 1024) { seq = job >> 8; int rem = job & 255; h = rem & 3; tok0 = seq * 4096 + (rem >> 2) * 64; valid = 64; }
  else { int j = job - 1024; seq = 4 + (j >> 2); h = j & 3; tok0 = NPT + (seq - 4) * 32; valid = 32; }
}
constexpr int G_SGD = 0;
constexpr int G_SHT = 4096;
constexpr int G_SSS = 5120;
constexpr int G_QD = 6144;
constexpr int G_KN = G_QD + 17408;
constexpr int G_P = G_KN + 17408;
constexpr int GS = 136, PS = 72;

#define GLA_LA(i_, valid_)                                                                       \
  ({                                                                                             \
    float x_ = g_bg;                                                                             \
    _Pragma("unroll") for (int r4 = 0; r4 < 4; ++r4) {                                           \
      const float4 gv = *(const float4*)(sGD + (i_) * 16 + r4 * 4);                              \
      x_ += gv.x * g_wg[r4 * 4] + gv.y * g_wg[r4 * 4 + 1] + gv.z * g_wg[r4 * 4 + 2] + gv.w * g_wg[r4 * 4 + 3]; \
    }                                                                                            \
    float la_ = logsigmoidf_(x_) * (1.f / 16.f);                                                 \
    if ((i_) >= (valid_)) la_ = 0.f;                                                             \
    la_;                                                                                         \
  })
#define GLA_CUMSUM(l_, h_, tok0_, valid_)                                                                          \
  const int g_tid = TID, g_d = g_tid & 127, g_half = g_tid >> 7;                                                    \
  float* sGD = (float*)(smem + G_SGD);                                                                              \
  float* sHT = (float*)(smem + G_SHT);                                                                              \
  {                                                                                                                 \
    _Pragma("unroll") for (int q = 0; q < 4; ++q) {                                                                 \
      const int idx = g_tid * 4 + q, i = idx >> 4, r = idx & 15;                                                    \
      const int ti = (i < valid_) ? i : (valid_ - 1);                                                               \
      sGD[idx] = bf2f(Y[(long)(tok0_ + ti) * LDY + YGD + r]);                                                       \
    }                                                                                                               \
  }                                                                                                                 \
  float g_wg[16];                                                                                                   \
  _Pragma("unroll") for (int r = 0; r < 16; ++r) g_wg[r] = p.in[9][(long)(l_ * 16 + r) * 512 + h_ * 128 + g_d];      \
  const float g_bg = p.in[10][l_ * 512 + h_ * 128 + g_d];                                                           \
  __syncthreads();                                                                                                  \
  {                                                                                                                 \
    float run = 0.f;                                                                                                \
    _Pragma("unroll 2") for (int ii = 0; ii < 32; ++ii) run += GLA_LA(g_half * 32 + ii, valid_);                    \
    sHT[g_half * 128 + g_d] = run;                                                                                  \
  }                                                                                                                 \
  __syncthreads();                                                                                                  \
  const float g_off = g_half ? sHT[g_d] : 0.f;                                                                      \
  const float g_bend = sHT[g_d] + sHT[128 + g_d];

__device__ __forceinline__ void gla_phase_a(const Ctx& cx, const Params& p, int l, int job) {
  const u16* Y = (const u16*)(cx.ws + WS_Y);
  u16* GST = (u16*)(cx.ws + WS_GST);
  float* GDEC = (float*)(cx.ws + WS_GDEC);
  int seq, h, tok0, valid;
  gla_job_decode(job, seq, h, tok0, valid);
  __syncthreads();
  GLA_CUMSUM(l, h, tok0, valid)
  u16* sKd = (u16*)(smem + G_QD);
  {
    float run = g_off;
#pragma unroll 4
    for (int ii = 0; ii < 32; ++ii) {
      const int i = g_half * 32 + ii;
      run += GLA_LA(i, valid);
      float kv = 0.f;
      if (i < valid) kv = bf2f(Y[(long)(tok0 + i) * LDY + YK + h * 128 + g_d]);
      sKd[i * GS + g_d] = f2bf(kv * __expf(g_bend - run));
    }
  }
  if (g_half == 0) GDEC[job * 128 + g_d] = __expf(g_bend);
  __syncthreads();
  const int wid = g_tid >> 6, lane = g_tid & 63, fr = lane & 15, fq = lane >> 4;
  bf16x8 Af[4][2];
#pragma unroll
  for (int mt = 0; mt < 4; ++mt)
#pragma unroll
    for (int ks = 0; ks < 2; ++ks)
#pragma unroll
      for (int jj = 0; jj < 8; ++jj) {
        int jrow = ks * 32 + fq * 8 + jj;
        jrow = jrow < valid ? jrow : valid - 1;
        Af[mt][ks][jj] = (short)Y[(long)(tok0 + jrow) * LDY + YV + h * 256 + wid * 64 + mt * 16 + fr];
      }
#pragma unroll 1
  for (int nt = 0; nt < 8; ++nt) {
    bf16x8 Bf[2];
#pragma unroll
    for (int ks = 0; ks < 2; ++ks)
#pragma unroll
      for (int jj = 0; jj < 8; ++jj) Bf[ks][jj] = (short)sKd[(ks * 32 + fq * 8 + jj) * GS + nt * 16 + fr];
    f32x4 acc[4];
#pragma unroll
    for (int mt = 0; mt < 4; ++mt) {
      acc[mt] = (f32x4){0.f, 0.f, 0.f, 0.f};
#pragma unroll
      for (int ks = 0; ks < 2; ++ks) acc[mt] = __builtin_amdgcn_mfma_f32_16x16x32_bf16(Af[mt][ks], Bf[ks], acc[mt], 0, 0, 0);
    }
#pragma unroll
    for (int mt = 0; mt < 4; ++mt)
#pragma unroll
      for (int jj = 0; jj < 4; ++jj) {
        const int er = wid * 64 + mt * 16 + fq * 4 + jj;
        GST[(long)job * 32768 + er * 128 + nt * 16 + fr] = f2bf(acc[mt][jj]);
      }
  }
}

__device__ __forceinline__ void gla_phase_c(const Ctx& cx, const Params& p, int l, int job) {
  const u16* Y = (const u16*)(cx.ws + WS_Y);
  const u16* GST = (const u16*)(cx.ws + WS_GST);
  u16* OG = (u16*)(cx.ws + WS_OG);
  int seq, h, tok0, valid;
  gla_job_decode(job, seq, h, tok0, valid);
  __syncthreads();
  GLA_CUMSUM(l, h, tok0, valid)
  (void)g_bend;
  u16* sQd = (u16*)(smem + G_QD);
  u16* sKn = (u16*)(smem + G_KN);
  u16* sP = (u16*)(smem + G_P);
  float* sSS = (float*)(smem + G_SSS);
  {
    float run = g_off;
#pragma unroll 4
    for (int ii = 0; ii < 32; ++ii) {
      const int i = g_half * 32 + ii;
      run += GLA_LA(i, valid);
      float qv = 0.f, kv = 0.f;
      if (i < valid) {
        qv = bf2f(Y[(long)(tok0 + i) * LDY + YQ + h * 128 + g_d]);
        kv = bf2f(Y[(long)(tok0 + i) * LDY + YK + h * 128 + g_d]);
      }
      sQd[i * GS + g_d] = f2bf(qv * __expf(run) * 0.08838834764831845f);
      sKn[i * GS + g_d] = f2bf(kv * __expf(-run));
    }
  }
  __syncthreads();
  const int wid = g_tid >> 6, lane = g_tid & 63, fr = lane & 15, fq = lane >> 4;
  {
    f32x4 sc[4];
#pragma unroll
    for (int jt = 0; jt < 4; ++jt) sc[jt] = (f32x4){0.f, 0.f, 0.f, 0.f};
#pragma unroll
    for (int ks = 0; ks < 4; ++ks) {
      bf16x8 a = *(const bf16x8*)(sQd + (wid * 16 + fr) * GS + ks * 32 + fq * 8);
#pragma unroll
      for (int jt = 0; jt < 4; ++jt) {
        bf16x8 b = *(const bf16x8*)(sKn + (jt * 16 + fr) * GS + ks * 32 + fq * 8);
        sc[jt] = __builtin_amdgcn_mfma_f32_16x16x32_bf16(a, b, sc[jt], 0, 0, 0);
      }
    }
#pragma unroll
    for (int jt = 0; jt < 4; ++jt)
#pragma unroll
      for (int jj = 0; jj < 4; ++jj) {
        const int i = wid * 16 + fq * 4 + jj, j = jt * 16 + fr;
        sP[i * PS + j] = f2bf(j <= i ? sc[jt][jj] : 0.f);
      }
  }
  __syncthreads();
  f32x4 acc[4][4];
  acc_zero(acc);
#pragma unroll 1
  for (int ks = 0; ks < 4; ++ks) {
    bf16x8 a[4];
#pragma unroll
    for (int mt = 0; mt < 4; ++mt) a[mt] = *(const bf16x8*)(sQd + (mt * 16 + fr) * GS + ks * 32 + fq * 8);
#pragma unroll
    for (int nt = 0; nt < 4; ++nt) {
      const bf16x8 b = *(const bf16x8*)(GST + (long)job * 32768 + (wid * 64 + nt * 16 + fr) * 128 + ks * 32 + fq * 8);
#pragma unroll
      for (int mt = 0; mt < 4; ++mt) acc[mt][nt] = __builtin_amdgcn_mfma_f32_16x16x32_bf16(a[mt], b, acc[mt][nt], 0, 0, 0);
    }
  }
#pragma unroll 1
  for (int ks = 0; ks < 2; ++ks) {
    bf16x8 a[4];
#pragma unroll
    for (int mt = 0; mt < 4; ++mt) a[mt] = *(const bf16x8*)(sP + (mt * 16 + fr) * PS + ks * 32 + fq * 8);
#pragma unroll
    for (int nt = 0; nt < 4; ++nt) {
      bf16x8 b;
#pragma unroll
      for (int jj = 0; jj < 8; ++jj) {
        int jrow = ks * 32 + fq * 8 + jj;
        jrow = jrow < valid ? jrow : valid - 1;
        b[jj] = (short)Y[(long)(tok0 + jrow) * LDY + YV + h * 256 + wid * 64 + nt * 16 + fr];
      }
#pragma unroll
      for (int mt = 0; mt < 4; ++mt) acc[mt][nt] = __builtin_amdgcn_mfma_f32_16x16x32_bf16(a[mt], b, acc[mt][nt], 0, 0, 0);
    }
  }
#pragma unroll
  for (int mt = 0; mt < 4; ++mt)
#pragma unroll
    for (int jj = 0; jj < 4; ++jj) {
      float s = 0.f;
#pragma unroll
      for (int nt = 0; nt < 4; ++nt) s += acc[mt][nt][jj] * acc[mt][nt][jj];
      s = row16_allsum(s);
      if (fr == 0) sSS[wid * 64 + mt * 16 + fq * 4 + jj] = s;
    }
  __syncthreads();
  const float* ng = p.in[11] + l * 1024 + h * 256;
#pragma unroll
  for (int mt = 0; mt < 4; ++mt)
#pragma unroll
    for (int jj = 0; jj < 4; ++jj) {
      const int i = mt * 16 + fq * 4 + jj;
      const float tot = sSS[i] + sSS[64 + i] + sSS[128 + i] + sSS[192 + i];
      const float rs = rsqrtf(tot * (1.f / 256.f) + 1e-6f);
      if (i < valid) {
#pragma unroll
        for (int nt = 0; nt < 4; ++nt) {
          const int e = wid * 64 + nt * 16 + fr;
          OG[(long)(tok0 + i) * 1024 + h * 256 + e] = f2bf(acc[mt][nt][jj] * rs * ng[e]);
        }
      }
    }
}

__device__ __forceinline__ void phase_mix1(const Ctx& cx, const Params& p, int l) {
  const int nj_gla = NGJOB, nj_lru = NMT * 8, nj_rw = NMT * 16;
  for (int job = BID; job < nj_gla + nj_lru + nj_rw; job += NBLK) {
    if (job < nj_gla) {
      gla_phase_a(cx, p, l, job);
    } else if (job < nj_gla + nj_lru) {
      const int jb = job - nj_gla, mt = jb >> 3, nb = jb & 7;
      const u16* XC = (const u16*)(cx.ws + WS_XC);
      const u16* WTL = (const u16*)(cx.ws + WS_WTLRU);
      u16* LLA = (u16*)(cx.ws + WS_LLA);
      u16* LVV = (u16*)(cx.ws + WS_LVV);
      const float* CSP = (const float*)(cx.ws + WS_CSP) + l * 1024;
      __syncthreads();
      {
        f32x4 acc[4][4];
        acc_zero(acc);
        gemm_mainloop(cx, acc, XC + (long)mt * 128 * 1024 + nb * 128, 1024, WTL + (long)((l * 2 + 0) * 8 + nb) * 16384, 128, 128);
        EPI4_BEGIN
          const int row = mt * 128 + lrow, col = nb * 128 + lcol;
          const float4 ba = *(const float4*)(p.in[15] + l * 1024 + col);
          const float4 sp = *(const float4*)(CSP + col);
          *(ushort4*)(LLA + (long)row * 1024 + col) = pack4(sigmoidf_(v[0] + ba.x) * sp.x, sigmoidf_(v[1] + ba.y) * sp.y,
                                                            sigmoidf_(v[2] + ba.z) * sp.z, sigmoidf_(v[3] + ba.w) * sp.w);
        EPI4_END
      }
      {
        f32x4 acc[4][4];
        acc_zero(acc);
        gemm_mainloop(cx, acc, XC + (long)mt * 128 * 1024 + nb * 128, 1024, WTL + (long)((l * 2 + 1) * 8 + nb) * 16384, 128, 128);
        EPI4_BEGIN
          const int row = mt * 128 + lrow, col = nb * 128 + lcol;
          const float4 bx = *(const float4*)(p.in[17] + l * 1024 + col);
          const ushort4 xc = *(const ushort4*)(XC + (long)row * 1024 + col);
          *(ushort4*)(LVV + (long)row * 1024 + col) = pack4(sigmoidf_(v[0] + bx.x) * bf2f(xc.x), sigmoidf_(v[1] + bx.y) * bf2f(xc.y),
                                                            sigmoidf_(v[2] + bx.z) * bf2f(xc.z), sigmoidf_(v[3] + bx.w) * bf2f(xc.w));
        EPI4_END
      }
    } else {
      const int jb = job - nj_gla - nj_lru, mt = jb >> 4, nt = (jb >> 1) & 7, which = jb & 1;
      const u16* RT = (const u16*)(cx.ws + WS_RT);
      const u16* WTR = (const u16*)(cx.ws + WS_WTRW);
      f32x4 acc[4][4];
      acc_zero(acc);
      __syncthreads();
      gemm_mainloop(cx, acc, RT + (long)mt * 128 * 128 + which * 64, 128, WTR + (long)(l * 2 + which) * 65536 + (long)nt * 128 * 64, 64, 64);
      if (which == 0) {
        float* RWW = (float*)(cx.ws + WS_RWW);
        EPI4_BEGIN
          const int row = mt * 128 + lrow, col = nt * 128 + lcol;
          const float4 w0 = *(const float4*)(p.in[20] + l * 1024 + col);
          float4 o;
          o.x = __expf(-sigmoidf_(w0.x + v[0]) * 0.6065306597126334f);
          o.y = __expf(-sigmoidf_(w0.y + v[1]) * 0.6065306597126334f);
          o.z = __expf(-sigmoidf_(w0.z + v[2]) * 0.6065306597126334f);
          o.w = __expf(-sigmoidf_(w0.w + v[3]) * 0.6065306597126334f);
          *(float4*)(RWW + (long)row * 1024 + col) = o;
        EPI4_END
      } else {
        u16* RWA = (u16*)(cx.ws + WS_RWA);
        EPI4_BEGIN
          const int row = mt * 128 + lrow, col = nt * 128 + lcol;
          const float4 a0 = *(const float4*)(p.in[22] + l * 1024 + col);
          *(ushort4*)(RWA + (long)row * 1024 + col) = pack4(sigmoidf_(a0.x + v[0]), sigmoidf_(a0.y + v[1]), sigmoidf_(a0.z + v[2]), sigmoidf_(a0.w + v[3]));
        EPI4_END
      }
    }
  }
}

__device__ __forceinline__ void lru_step4(const ushort4 la4, const ushort4 vv4, float (&h)[4], float (&A)[4], bool trackA) {
  const float la[4] = {bf2f(la4.x), bf2f(la4.y), bf2f(la4.z), bf2f(la4.w)};
  const float vv[4] = {bf2f(vv4.x), bf2f(vv4.y), bf2f(vv4.z), bf2f(vv4.w)};
#pragma unroll
  for (int j = 0; j < 4; ++j) {
    const float a = __expf(la[j]);
    const float u = sqrtf(fmaxf(1.f - a * a, 0.f)) * vv[j];
    if (trackA) A[j] *= a;
    h[j] = a * h[j] + u;
  }
}
__device__ __forceinline__ void phase_mix2(const Ctx& cx, const Params& p, int l, bool shadow = false) {
  u16* GST = (u16*)(cx.ws + WS_GST);
  const float* GDEC = (const float*)(cx.ws + WS_GDEC);
  const int gtid = BID * 256 + TID, gstr = NBLK * 256;
  for (int it = gtid; it < 48 * 4096; it += gstr) {
    const int sh = it >> 12, idx = (it & 4095) * 8, d = idx & 127, e = idx >> 7;
    float S[8];
    int job0, nch, jstride;
    float* outp;
    if (sh < 16) {
      const int seq = sh >> 2, h = sh & 3;
#pragma unroll
      for (int j = 0; j < 8; ++j) S[j] = 0.f;
      job0 = seq * 256 + h; nch = 64; jstride = 4;
      outp = cx.out + O_GLAP + ((long)((l * 4 + seq) * 4 + h)) * 32768 + d * 256 + e;
    } else {
      const int j_ = sh - 16, b = j_ >> 2, h = j_ & 3;
      const long so = ((long)((l * 8 + b) * 4 + h)) * 32768 + d * 256 + e;
#pragma unroll
      for (int j = 0; j < 8; ++j) S[j] = p.in[2][so + j * 256];
      job0 = 1024 + j_; nch = 1; jstride = 0;
      outp = cx.out + O_GLAS + so;
    }
    for (int ch0 = 0; ch0 < nch; ch0 += 8) {
      bf16x8 u[8];
      float4 da[8], db[8];
#pragma unroll
      for (int q = 0; q < 8; ++q) {
        if (ch0 + q < nch) {
          const int job = job0 + (ch0 + q) * jstride;
          u[q] = *(const bf16x8*)(GST + (long)job * 32768 + idx);
          da[q] = *(const float4*)(GDEC + job * 128 + d);
          db[q] = *(const float4*)(GDEC + job * 128 + d + 4);
        }
      }
#pragma unroll
      for (int q = 0; q < 8; ++q) {
        if (ch0 + q < nch) {
          const int job = job0 + (ch0 + q) * jstride;
          const float dd[8] = {da[q].x, da[q].y, da[q].z, da[q].w, db[q].x, db[q].y, db[q].z, db[q].w};
          bf16x8 o;
#pragma unroll
          for (int j = 0; j < 8; ++j) {
            o[j] = (short)f2bf(S[j]);
            S[j] = S[j] * dd[j] + bf2f((u16)u[q][j]);
          }
          if (!shadow) *(bf16x8*)(GST + (long)job * 32768 + idx) = o;
        }
      }
    }
#pragma unroll
    for (int j = 0; j < 8; ++j) outp[j * 256] = S[j];
  }
  const u16* LLA = (const u16*)(cx.ws + WS_LLA);
  const u16* LVV = (const u16*)(cx.ws + WS_LVV);
  float* LCH = (float*)(cx.ws + WS_LCH);
  for (int it = gtid; it < 4 * 64 * 256; it += gstr) {
    const int c = (it & 255) * 4, ch = (it >> 8) & 63, seq = it >> 14;
    const long t0 = (long)seq * 4096 + ch * 64;
    float A[4] = {1.f, 1.f, 1.f, 1.f}, H[4] = {0.f, 0.f, 0.f, 0.f};
#pragma unroll 16
    for (int t = 0; t < 64; ++t) {
      const ushort4 la4 = *(const ushort4*)(LLA + (t0 + t) * 1024 + c);
      const ushort4 vv4 = *(const ushort4*)(LVV + (t0 + t) * 1024 + c);
      lru_step4(la4, vv4, H, A, true);
    }
    *(float4*)(LCH + (long)(seq * 64 + ch) * 2048 + c) = make_float4(A[0], A[1], A[2], A[3]);
    *(float4*)(LCH + (long)(seq * 64 + ch) * 2048 + 1024 + c) = make_float4(H[0], H[1], H[2], H[3]);
  }
}

__device__ __forceinline__ void phase_mix3(const Ctx& cx, const Params& p, int l) {
  const int nblk_lru = (4 * 64 * 256 + 8 * 256) / 256;
  for (int job = BID; job < NGJOB + nblk_lru; job += NBLK) {
    if (job < NGJOB) {
      gla_phase_c(cx, p, l, job);
    } else {
      const int it = (job - NGJOB) * 256 + TID;
      const u16* __restrict__ LLA = (const u16*)(cx.ws + WS_LLA);
      const u16* __restrict__ LVV = (const u16*)(cx.ws + WS_LVV);
      const float* __restrict__ LCH = (const float*)(cx.ws + WS_LCH);
      u16* __restrict__ OL = (u16*)(cx.ws + WS_OL);
      int c, nt;
      long t0;
      float h[4] = {0.f, 0.f, 0.f, 0.f}, dummy[4];
      float* hout = nullptr;
      if (it < 4 * 64 * 256) {
        c = (it & 255) * 4;
        const int ch = (it >> 8) & 63, seq = it >> 14;
        t0 = (long)seq * 4096 + ch * 64;
        nt = 64;
#pragma unroll 8
        for (int q = 0; q < ch; ++q) {
          const float4 Aq = *(const float4*)(LCH + (long)(seq * 64 + q) * 2048 + c);
          const float4 Hq = *(const float4*)(LCH + (long)(seq * 64 + q) * 2048 + 1024 + c);
          h[0] = Aq.x * h[0] + Hq.x; h[1] = Aq.y * h[1] + Hq.y; h[2] = Aq.z * h[2] + Hq.z; h[3] = Aq.w * h[3] + Hq.w;
        }
        if (ch == 63) hout = cx.out + O_LHP + (long)(l * 4 + seq) * 1024 + c;
      } else {
        const int r = it - 4 * 64 * 256;
        c = (r & 255) * 4;
        const int b = r >> 8;
        t0 = NPT + b * 32;
        nt = 32;
        const float4 h0 = *(const float4*)(p.in[3] + (long)(l * 8 + b) * 1024 + c);
        h[0] = h0.x; h[1] = h0.y; h[2] = h0.z; h[3] = h0.w;
        hout = cx.out + O_LHS + (long)(l * 8 + b) * 1024 + c;
      }
#pragma unroll 8
      for (int t = 0; t < nt; ++t) {
        const ushort4 la4 = *(const ushort4*)(LLA + (t0 + t) * 1024 + c);
        const ushort4 vv4 = *(const ushort4*)(LVV + (t0 + t) * 1024 + c);
        lru_step4(la4, vv4, h, dummy, false);
        *(ushort4*)(OL + (t0 + t) * 1024 + c) = pack4(h[0], h[1], h[2], h[3]);
      }
      if (hout) *(float4*)hout = make_float4(h[0], h[1], h[2], h[3]);
    }
  }
}

__device__ __forceinline__ float row8_allsum(float x) {
  DPP_ADD(x, 0xB1);
  DPP_ADD(x, 0x4E);
  DPP_ADD(x, 0x141);
  return x;
}
__device__ __forceinline__ void bf8_to_f(const bf16x8 v, float (&o)[8]) {
#pragma unroll
  for (int j = 0; j < 8; ++j) o[j] = bf2f((u16)v[j]);
}
__device__ __forceinline__ void phase_rwprep(const Ctx& cx, const Params& p, int l, bool shadow = false) {
  const u16* __restrict__ Y = (const u16*)(cx.ws + WS_Y);
  u16* __restrict__ BR = (u16*)(cx.ws + WS_XC);
  u16* __restrict__ BK = (u16*)(cx.ws + WS_LVV);
  u16* __restrict__ BKK = (u16*)(cx.ws + WS_GST);
  u16* __restrict__ BKA = BKK + (long)NTOK * 1024;
  const u16* __restrict__ BA = (const u16*)(cx.ws + WS_RWA);
  u16* __restrict__ BV = (u16*)(cx.ws + WS_RWA);
  u16* __restrict__ REX = (u16*)(cx.ws + WS_LLA);
  const int ts = TID >> 7, c = (TID & 127) * 8;
  float mur[8], muk[8], muv[8], kkc[8], kac[8], rkc[8];
#pragma unroll
  for (int j = 0; j < 8; ++j) {
    mur[j] = p.in[19][l * 3200 + c + j];
    muk[j] = p.in[19][l * 3200 + 1024 + c + j];
    muv[j] = p.in[19][l * 3200 + 2048 + c + j];
    kkc[j] = p.in[24][l * 1024 + c + j];
    kac[j] = p.in[25][l * 1024 + c + j];
    rkc[j] = p.in[26][l * 1024 + c + j];
  }
#pragma unroll 2
  for (int tb = BID * 2; tb < NTOK; tb += NBLK * 2) {
    const int tok = tb + ts;
    int seq, pos, L;
    tok_decode(tok, seq, pos, L);
    const u16* yr = Y + (long)tok * LDY + YRW + c;
    float cr[8], ck[8], cv[8], af[8], pr[8], pk[8], pv[8];
    bf8_to_f(*(const bf16x8*)(yr), cr);
    bf8_to_f(*(const bf16x8*)(yr + 1024), ck);
    bf8_to_f(*(const bf16x8*)(yr + 2048), cv);
    bf8_to_f(*(const bf16x8*)(BA + (long)tok * 1024 + c), af);
    if (pos > 0) {
      bf8_to_f(*(const bf16x8*)(yr - LDY), pr);
      bf8_to_f(*(const bf16x8*)(yr - LDY + 1024), pk);
      bf8_to_f(*(const bf16x8*)(yr - LDY + 2048), pv);
    } else if (seq >= 4) {
      const float* s0 = p.in[6] + (long)(l * 8 + (seq - 4)) * 3200 + c;
#pragma unroll
      for (int j = 0; j < 8; ++j) { pr[j] = s0[j]; pk[j] = s0[1024 + j]; pv[j] = s0[2048 + j]; }
    } else {
#pragma unroll
      for (int j = 0; j < 8; ++j) { pr[j] = 0.f; pk[j] = 0.f; pv[j] = 0.f; }
    }
    float r[8], kp[8], v[8], kkr[8];
    float n2 = 0.f, rk = 0.f;
#pragma unroll
    for (int j = 0; j < 8; ++j) {
      r[j] = cr[j] + (pr[j] - cr[j]) * mur[j];
      const float k = ck[j] + (pk[j] - ck[j]) * muk[j];
      v[j] = cv[j] + (pv[j] - cv[j]) * muv[j];
      kkr[j] = k * kkc[j];
      n2 += kkr[j] * kkr[j];
      kp[j] = k * (1.f + (af[j] - 1.f) * kac[j]);
      rk += r[j] * kp[j] * rkc[j];
    }
    n2 = row8_allsum(n2);
    rk = row8_allsum(rk);
    const float rn = rsqrtf(n2 + 1e-12f);
    bf16x8 o_r, o_k, o_kk, o_ka, o_v, o_e;
#pragma unroll
    for (int j = 0; j < 8; ++j) {
      o_r[j] = (short)f2bf(r[j]);
      o_k[j] = (short)f2bf(kp[j]);
      o_kk[j] = (short)f2bf(kkr[j] * rn);
      o_ka[j] = (short)f2bf(kkr[j] * rn * af[j]);
      o_v[j] = (short)f2bf(v[j]);
      o_e[j] = (short)f2bf(rk * v[j]);
    }
    const long o = (long)tok * 1024 + c;
    *(bf16x8*)(BR + o) = o_r;
    *(bf16x8*)(BK + o) = o_k;
    *(bf16x8*)(BKK + o) = o_kk;
    *(bf16x8*)(BKA + o) = o_ka;
    if (!shadow) *(bf16x8*)(BV + o) = o_v;
    *(bf16x8*)(REX + o) = o_e;
  }
}

__device__ __forceinline__ void inproj2_tile(const Ctx& cx, int mt, int nt, const float* gnw, const float* gnb);
constexpr int RT_T = 16;
typedef float f32x2 __attribute__((ext_vector_type(2)));
__device__ __forceinline__ void phase_rwscan(const Ctx& cx, const Params& p, int l, int l2) {
  const u16* BR = (const u16*)(cx.ws + WS_XC);
  const u16* BK = (const u16*)(cx.ws + WS_LVV);
  const u16* BKK = (const u16*)(cx.ws + WS_GST);
  const u16* BKA = BKK + (long)NTOK * 1024;
  const u16* BV = (const u16*)(cx.ws + WS_RWA);
  const float* RWW = (const float*)(cx.ws + WS_RWW);
  u16* OR = (u16*)(cx.ws + WS_OR);
  float* sR = (float*)smem;
  float* sW = sR + RT_T * 64;
  float* sK = sW + RT_T * 64;
  float* sKK = sK + RT_T * 64;
  float* sKA = sKK + RT_T * 64;
  float* sV = sKA + RT_T * 64;
  float* sY = sV + RT_T * 64;
  const int tid = TID, wave = tid >> 6, lane = tid & 63;
  int* ctl = (int*)(cx.ws + WS_CTL);
  volatile int* s_ctl = (volatile int*)(smem + SMEM_CTL);
  if (tid == 0) {
    const unsigned xcc = (unsigned)__builtin_amdgcn_s_getreg((3 << 11) | 20) & 0xFu;
    const unsigned cu = ((unsigned)__builtin_amdgcn_s_getreg(63492) >> 8) & 0xFFu;
    const int key = l2 * 4096 + xcc * 256 + cu;
    int role;
    if (atomicAdd(ctl + CTL_CLAIM + key, 1) == 0) {
      const int rank = atomicAdd(ctl + CTL_NCU + l2, 1);
      role = (rank < 128) ? 2 : 1;
      __hip_atomic_store(ctl + CTL_ROLE + key, role, __ATOMIC_RELAXED, __HIP_MEMORY_SCOPE_AGENT);
    } else {
      int spins = 0;
      while ((role = __hip_atomic_load(ctl + CTL_ROLE + key, __ATOMIC_RELAXED, __HIP_MEMORY_SCOPE_AGENT)) == 0 && ++spins < (1 << 20)) __builtin_amdgcn_s_sleep(1);
      if (role == 0) role = 1;
    }
    s_ctl[1] = (role == 2) ? 1 : 0;
  }
  __syncthreads();
  const int first = s_ctl[1];
  int stage = first ? 0 : 1;
  for (;;) {
    __syncthreads();
    if (tid == 0) {
      int job = -1, st = stage;
      while (job < 0 && st < 4) {
        if (st == 0 || st == 3) {
          const int j = atomicAdd(ctl + CTL_QP + l2, 1);
          if (j < 256) job = j; else ++st;
        } else if (st == 1) {
          const int j = atomicAdd(ctl + CTL_QS + l2, 1);
          if (j < 512) job = 256 + j; else ++st;
        } else {
          const int total = NMT * 40;
          for (int a = 0; a < 8 && job < 0; ++a) {
            const int x = (BID + a) & 7;
            const int c = atomicAdd(ctl + CTL_QG + l2 * 8 + x, 1);
            const int t = ((c >> 6) * 8 + x) * 64 + (c & 63);
            if (t < total) job = 1024 + t;
          }
          if (job < 0) ++st;
        }
      }
      s_ctl[2] = job;
      s_ctl[3] = st;
    }
    __syncthreads();
    const int job = s_ctl[2];
    stage = s_ctl[3];
    if (job < 0) break;
    if (stage == 0) stage = 1;
    if (job >= 1024) {
      const int t = job - 1024, sn = t / (NMT * 8), r = t % (NMT * 8);
      const int mt = r >> 3, ni = sn * 8 + (r & 7);
      inproj2_tile(cx, mt, ni < 16 ? ni : ni + 8, nullptr, nullptr);
      continue;
    }
    int seq, h, rq, L, t0;
    if (job < 256) { seq = job >> 6; h = (job >> 2) & 15; rq = job & 3; L = 4096; t0 = seq * 4096; }
    else { int j = job - 256; seq = 4 + (j >> 6); h = (j >> 2) & 15; rq = j & 3; L = 32; t0 = NPT + (seq - 4) * 32; }
    const int rloc = wave * 4 + (lane >> 4), row = rq * 16 + rloc, kq = lane & 15;
    float S0, S1, S2, S3;
    if (seq >= 4) {
      const float4 s = *(const float4*)(p.in[5] + ((((long)(l * 8 + (seq - 4)) * 16 + h) * 64 + row) * 64 + kq * 4));
      S0 = s.x; S1 = s.y; S2 = s.z; S3 = s.w;
    } else { S0 = S1 = S2 = S3 = 0.f; }
    ushort4 gr0, gk0, gkk0, gka0, gv0, gr1, gk1, gkk1, gka1, gv1;
    float4 gw0, gw1;
    const int ntiles = L / RT_T;
    const int pf_tt = tid >> 4, pf_c4 = (tid & 15) * 4;
#define RW_LOAD(tile_, Q)                                                                      \
    {                                                                                          \
      const long o = (long)(t0 + (tile_) * RT_T + pf_tt) * 1024 + h * 64 + pf_c4;              \
      gr##Q = *(const ushort4*)(BR + o);                                                       \
      gk##Q = *(const ushort4*)(BK + o);                                                       \
      gkk##Q = *(const ushort4*)(BKK + o);                                                     \
      gka##Q = *(const ushort4*)(BKA + o);                                                     \
      gv##Q = *(const ushort4*)(BV + o);                                                       \
      gw##Q = *(const float4*)(RWW + o);                                                       \
    }
#define RW_STORE(Q)                                                                                              \
    {                                                                                                            \
      const int o = pf_tt * 64 + pf_c4;                                                                          \
      *(float4*)(sR + o) = make_float4(bf2f(gr##Q.x), bf2f(gr##Q.y), bf2f(gr##Q.z), bf2f(gr##Q.w));              \
      *(float4*)(sK + o) = make_float4(bf2f(gk##Q.x), bf2f(gk##Q.y), bf2f(gk##Q.z), bf2f(gk##Q.w));              \
      *(float4*)(sKK + o) = make_float4(bf2f(gkk##Q.x), bf2f(gkk##Q.y), bf2f(gkk##Q.z), bf2f(gkk##Q.w));         \
      *(float4*)(sKA + o) = make_float4(bf2f(gka##Q.x), bf2f(gka##Q.y), bf2f(gka##Q.z), bf2f(gka##Q.w));         \
      *(float4*)(sV + o) = make_float4(bf2f(gv##Q.x), bf2f(gv##Q.y), bf2f(gv##Q.z), bf2f(gv##Q.w));              \
      *(float4*)(sW + o) = gw##Q;                                                                                \
    }
#define RW_LD(tt_, X)                                                 \
      X##w = *(const float4*)(sW + (tt_) * 64 + kq * 4);               \
      X##k = *(const float4*)(sK + (tt_) * 64 + kq * 4);               \
      X##kk = *(const float4*)(sKK + (tt_) * 64 + kq * 4);             \
      X##ka = *(const float4*)(sKA + (tt_) * 64 + kq * 4);             \
      X##r = *(const float4*)(sR + (tt_) * 64 + kq * 4);               \
      X##v = sV[(tt_) * 64 + row];
#define LO2(v4) ((f32x2){(v4).x, (v4).y})
#define HI2(v4) ((f32x2){(v4).z, (v4).w})
#define RW_STEP(tt_, X)                                                                            \
      {                                                                                            \
        f32x2 d = S01 * LO2(X##kk);                                                                \
        d = __builtin_elementwise_fma(S23, HI2(X##kk), d);                                         \
        float sk = d.x + d.y;                                                                      \
        sk = row16_allsum(sk);                                                                     \
        const f32x2 vv2 = (f32x2){X##v, X##v}, nsk2 = (f32x2){-sk, -sk};                           \
        f32x2 t01 = LO2(X##k) * vv2, t23 = HI2(X##k) * vv2;                                        \
        t01 = __builtin_elementwise_fma(LO2(X##ka), nsk2, t01);                                    \
        t23 = __builtin_elementwise_fma(HI2(X##ka), nsk2, t23);                                    \
        S01 = __builtin_elementwise_fma(S01, LO2(X##w), t01);                                      \
        S23 = __builtin_elementwise_fma(S23, HI2(X##w), t23);                                      \
        f32x2 y2 = S01 * LO2(X##r);                                                                \
        y2 = __builtin_elementwise_fma(S23, HI2(X##r), y2);                                        \
        sY[(tt_) * 256 + wave * 64 + lane] = y2.x + y2.y;                                          \
      }                                                                                            \
      __builtin_amdgcn_sched_barrier(0);
#define RW_TILE(tile_, Q)                                                                          \
    {                                                                                              \
      RW_STORE(Q)                                                                                  \
      __syncthreads();                                                                             \
      if ((tile_) + 2 < ntiles) { RW_LOAD((tile_) + 2, Q) }                                        \
      float4 Aw, Ak, Akk, Aka, Ar, Bw, Bk, Bkk, Bka, Br;                                           \
      float Av, Bv;                                                                                \
      RW_LD(0, A)                                                                                  \
      _Pragma("unroll 2") for (int tt = 0; tt < RT_T; tt += 2) {                                   \
        RW_LD(tt + 1, B)                                                                           \
        __builtin_amdgcn_sched_barrier(0);                                                         \
        RW_STEP(tt, A)                                                                             \
        { const int tn = (tt + 2 < RT_T) ? tt + 2 : tt; RW_LD(tn, A) }                             \
        __builtin_amdgcn_sched_barrier(0);                                                         \
        RW_STEP(tt + 1, B)                                                                         \
      }                                                                                            \
      __syncthreads();                                                                             \
      {                                                                                            \
        const int tt = tid >> 4, rr = tid & 15;                                                    \
        const float4 y0 = *(const float4*)(sY + tt * 256 + rr * 16), y1 = *(const float4*)(sY + tt * 256 + rr * 16 + 4);      \
        const float4 y2 = *(const float4*)(sY + tt * 256 + rr * 16 + 8), y3 = *(const float4*)(sY + tt * 256 + rr * 16 + 12); \
        const float ys = ((y0.x + y0.y) + (y0.z + y0.w)) + ((y1.x + y1.y) + (y1.z + y1.w)) + ((y2.x + y2.y) + (y2.z + y2.w)) + ((y3.x + y3.y) + (y3.z + y3.w)); \
        OR[(long)(t0 + (tile_) * RT_T + tt) * 1024 + h * 64 + rq * 16 + rr] = f2bf(ys);             \
      }                                                                                            \
    }
    f32x2 S01, S23;
    S01.x = S0; S01.y = S1; S23.x = S2; S23.y = S3;
    RW_LOAD(0, 0)
    if (ntiles > 1) { RW_LOAD(1, 1) }
    for (int tile = 0; tile < ntiles; tile += 2) {
      RW_TILE(tile, 0)
      if (tile + 1 < ntiles) RW_TILE(tile + 1, 1)
    }
#undef RW_TILE
#undef RW_LD
#undef RW_STEP
#undef LO2
#undef HI2
#undef RW_STORE
#undef RW_LOAD
    const float S0o = S01.x, S1o = S01.y, S2o = S23.x, S3o = S23.y;
    float* so = (seq < 4) ? (cx.out + O_RWP + ((((long)(l * 4 + seq) * 16 + h) * 64 + row) * 64 + kq * 4))
                          : (cx.out + O_RWS + ((((long)(l * 8 + (seq - 4)) * 16 + h) * 64 + row) * 64 + kq * 4));
    *(float4*)so = make_float4(S0o, S1o, S2o, S3o);
    __syncthreads();
  }
}

__device__ __forceinline__ void phase_rwgn(const Ctx& cx, const Params& p, int l) {
  u16* __restrict__ OR = (u16*)(cx.ws + WS_OR);
  const u16* __restrict__ ORr = (const u16*)(cx.ws + WS_OR);
  const u16* __restrict__ REX = (const u16*)(cx.ws + WS_LLA);
  const int c = TID * 4;
  const float4 gw = *(const float4*)(p.in[27] + l * 1024 + c);
  const float4 gb = *(const float4*)(p.in[28] + l * 1024 + c);
#pragma unroll 4
  for (int tok = BID; tok < NTOK; tok += NBLK) {
    const ushort4 yv = *(const ushort4*)(ORr + (long)tok * 1024 + c);
    const ushort4 ev = *(const ushort4*)(REX + (long)tok * 1024 + c);
    const float y0 = bf2f(yv.x), y1 = bf2f(yv.y), y2 = bf2f(yv.z), y3 = bf2f(yv.w);
    float s = y0 + y1 + y2 + y3, ss = y0 * y0 + y1 * y1 + y2 * y2 + y3 * y3;
    s = row16_allsum(s);
    ss = row16_allsum(ss);
    const float mean = s * (1.f / 64.f);
    const float var = fmaxf(ss * (1.f / 64.f) - mean * mean, 0.f);
    const float rs = rsqrtf(var + 64e-5f);
    ushort4 o;
    o.x = f2bf((y0 - mean) * rs * gw.x + gb.x + bf2f(ev.x));
    o.y = f2bf((y1 - mean) * rs * gw.y + gb.y + bf2f(ev.y));
    o.z = f2bf((y2 - mean) * rs * gw.z + gb.z + bf2f(ev.z));
    o.w = f2bf((y3 - mean) * rs * gw.w + gb.w + bf2f(ev.w));
    *(ushort4*)(OR + (long)tok * 1024 + c) = o;
  }
}

__device__ __forceinline__ void inproj2_tile(const Ctx& cx, int mt, int nt, const float* gnw, const float* gnb) {
  const u16* XN = (const u16*)(cx.ws + WS_XN);
  const u16* WT = (const u16*)(cx.ws + WS_WTIN) + (long)6400 * 1024;
  u16* Y = (u16*)(cx.ws + WS_Y);
  f32x4 acc[4][4];
  acc_zero(acc);
  gemm_mainloop(cx, acc, XN + (long)mt * 128 * 1024, 1024, WT + (long)nt * 128 * 1024, 1024, 1024);
  const int grp = nt >> 3;
  if (grp == 2) {
    const u16* OR = (const u16*)(cx.ws + WS_OR);
    const u16* REX = (const u16*)(cx.ws + WS_LLA);
    int e_z = 0; asm volatile("" : "+v"(e_z));
    const int e_tid = TID + e_z, e_wid = e_tid >> 6, e_lane = e_tid & 63, e_wr = e_wid >> 1, e_wc = e_wid & 1, e_fr = e_lane & 15, e_fq = e_lane >> 4;
#pragma unroll
    for (int m = 0; m < 4; ++m) {
      __builtin_amdgcn_sched_barrier(0);
      const int row = mt * 128 + e_wr * 64 + m * 16 + e_fr;
      const int cb = (nt & 7) * 128 + e_wc * 64 + e_fq * 4;
      ushort4 yv[4];
      float s = 0.f, ss = 0.f;
#pragma unroll
      for (int n = 0; n < 4; ++n) {
        yv[n] = *(const ushort4*)(OR + (long)row * 1024 + cb + n * 16);
        const float y0 = bf2f(yv[n].x), y1 = bf2f(yv[n].y), y2 = bf2f(yv[n].z), y3 = bf2f(yv[n].w);
        s += (y0 + y1) + (y2 + y3);
        ss += (y0 * y0 + y1 * y1) + (y2 * y2 + y3 * y3);
      }
      s += __shfl_xor(s, 16); ss += __shfl_xor(ss, 16);
      s += __shfl_xor(s, 32); ss += __shfl_xor(ss, 32);
      const float mean = s * (1.f / 64.f);
      const float rs = rsqrtf(fmaxf(ss * (1.f / 64.f) - mean * mean, 0.f) + 64e-5f);
#pragma unroll
      for (int n = 0; n < 4; ++n) {
        const int col = cb + n * 16;
        const ushort4 ev = *(const ushort4*)(REX + (long)row * 1024 + col);
        const float4 gw = *(const float4*)(gnw + col), gb = *(const float4*)(gnb + col);
        const f32x4 v = acc[m][n];
        const float o0 = (bf2f(yv[n].x) - mean) * rs * gw.x + gb.x + bf2f(ev.x);
        const float o1 = (bf2f(yv[n].y) - mean) * rs * gw.y + gb.y + bf2f(ev.y);
        const float o2 = (bf2f(yv[n].z) - mean) * rs * gw.z + gb.z + bf2f(ev.z);
        const float o3 = (bf2f(yv[n].w) - mean) * rs * gw.w + gb.w + bf2f(ev.w);
        *(ushort4*)(Y + (long)row * LDY + nt * 128 + e_wc * 64 + n * 16 + e_fq * 4) = pack4(o0 * siluf_(v[0]), o1 * siluf_(v[1]), o2 * siluf_(v[2]), o3 * siluf_(v[3]));
      }
    }
  } else if (grp < 3) {
    const u16* O = (const u16*)(cx.ws + (grp == 0 ? WS_OG : WS_OL));
    EPI4_BEGIN
      const int row = mt * 128 + lrow, col = (nt & 7) * 128 + lcol;
      const ushort4 ov = *(const ushort4*)(O + (long)row * 1024 + col);
      *(ushort4*)(Y + (long)row * LDY + nt * 128 + lcol) = pack4(bf2f(ov.x) * siluf_(v[0]), bf2f(ov.y) * siluf_(v[1]), bf2f(ov.z) * siluf_(v[2]), bf2f(ov.w) * siluf_(v[3]));
    EPI4_END
  } else {
    EPI4_BEGIN
      const int row = mt * 128 + lrow;
      *(ushort4*)(Y + (long)row * LDY + nt * 128 + lcol) = pack4(sigmoidf_(v[0]), sigmoidf_(v[1]), sigmoidf_(v[2]), sigmoidf_(v[3]));
    EPI4_END
  }
}
__device__ __forceinline__ void inproj2_tile160_rw(const Ctx& cx, int mt, int nt, const float* gnw, const float* gnb) {
  const u16* XN = (const u16*)(cx.ws + WS_XN);
  const u16* WT = (const u16*)(cx.ws + WS_WTIN) + (long)6400 * 1024;
  u16* Y = (u16*)(cx.ws + WS_Y);
  f32x4 acc[5][4];
  acc_zero5(acc);
  gemm_mainloop3(cx, acc, XN + (long)mt * 160 * 1024, 1024, WT + (long)nt * 128 * 1024, 1024, 1024);
  const u16* OR = (const u16*)(cx.ws + WS_OR);
  const u16* REX = (const u16*)(cx.ws + WS_LLA);
  int e_z = 0; asm volatile("" : "+v"(e_z));
  const int e_tid = TID + e_z, e_wid = e_tid >> 6, e_lane = e_tid & 63, e_wr = e_wid >> 1, e_wc = e_wid & 1, e_fr = e_lane & 15, e_fq = e_lane >> 4;
#pragma unroll
  for (int m = 0; m < 5; ++m) {
    __builtin_amdgcn_sched_barrier(0);
    const int row = mt * 160 + e_wr * 80 + m * 16 + e_fr;
    const int cb = (nt & 7) * 128 + e_wc * 64 + e_fq * 4;
    ushort4 yv[4];
    float s_ = 0.f, ss = 0.f;
#pragma unroll
    for (int n = 0; n < 4; ++n) {
      yv[n] = *(const ushort4*)(OR + (long)row * 1024 + cb + n * 16);
      const float y0 = bf2f(yv[n].x), y1 = bf2f(yv[n].y), y2 = bf2f(yv[n].z), y3 = bf2f(yv[n].w);
      s_ += (y0 + y1) + (y2 + y3);
      ss += (y0 * y0 + y1 * y1) + (y2 * y2 + y3 * y3);
    }
    s_ += __shfl_xor(s_, 16); ss += __shfl_xor(ss, 16);
    s_ += __shfl_xor(s_, 32); ss += __shfl_xor(ss, 32);
    const float mean = s_ * (1.f / 64.f);
    const float rs = rsqrtf(fmaxf(ss * (1.f / 64.f) - mean * mean, 0.f) + 64e-5f);
#pragma unroll
    for (int n = 0; n < 4; ++n) {
      const int col = cb + n * 16;
      const ushort4 ev = *(const ushort4*)(REX + (long)row * 1024 + col);
      const float4 gw = *(const float4*)(gnw + col), gb = *(const float4*)(gnb + col);
      const f32x4 v = acc[m][n];
      const float o0 = (bf2f(yv[n].x) - mean) * rs * gw.x + gb.x + bf2f(ev.x);
      const float o1 = (bf2f(yv[n].y) - mean) * rs * gw.y + gb.y + bf2f(ev.y);
      const float o2 = (bf2f(yv[n].z) - mean) * rs * gw.z + gb.z + bf2f(ev.z);
      const float o3 = (bf2f(yv[n].w) - mean) * rs * gw.w + gb.w + bf2f(ev.w);
      *(ushort4*)(Y + (long)row * LDY + nt * 128 + e_wc * 64 + n * 16 + e_fq * 4) = pack4(o0 * siluf_(v[0]), o1 * siluf_(v[1]), o2 * siluf_(v[2]), o3 * siluf_(v[3]));
    }
  }
}
__device__ __forceinline__ void phase_inproj2(const Ctx& cx, const Params& p, int l) {
  TILE3_LOOP_BEGIN(8)
    inproj2_tile160_rw(cx, mt, nt + 16, p.in[27] + l * 1024, p.in[28] + l * 1024);
  TILE_LOOP_END
}

template <int B>
__device__ __forceinline__ void merge_step(const Ctx& cx, int l, int mt, int nt) {
  const u16* Y = (const u16*)(cx.ws + WS_Y);
  const u16* WTP = (const u16*)(cx.ws + WS_WTP);
  u16* MG = (u16*)(cx.ws + WS_XC);
  float* TF = (float*)(cx.ws + WS_RWW);
  f32x4 acc[5][4];
  acc_zero5(acc);
  gemm_mainloop3(cx, acc, Y + (long)mt * 160 * LDY + B * 1024, LDY, WTP + (long)(l * 4 + B) * 1048576 + (long)nt * 128 * 1024, 1024, 1024);
  EPI5_BEGIN
    const int row = mt * 160 + lrow, col = nt * 128 + lcol;
    const ushort4 g = *(const ushort4*)(Y + (long)row * LDY + 3072 + B * 1024 + col);
    float4 t = make_float4(bf2f(g.x) * v[0], bf2f(g.y) * v[1], bf2f(g.z) * v[2], bf2f(g.w) * v[3]);
    if (B > 0) {
      const float4 o = *(const float4*)(TF + (long)row * 1024 + col);
      t.x += o.x; t.y += o.y; t.z += o.z; t.w += o.w;
    }
    if (B < 2) *(float4*)(TF + (long)row * 1024 + col) = t;
    else *(ushort4*)(MG + (long)row * 1024 + col) = pack4(t.x, t.y, t.z, t.w);
  EPI5_END
}
__device__ __forceinline__ void phase_merge(const Ctx& cx, const Params& p, int l) {
  TILE3_LOOP_BEGIN(8)
    merge_step<0>(cx, l, mt, nt);
    merge_step<1>(cx, l, mt, nt);
    merge_step<2>(cx, l, mt, nt);
  TILE_LOOP_END
}

__device__ __forceinline__ void phase_out(const Ctx& cx, const Params& p, int l) {
  const u16* MG = (const u16*)(cx.ws + WS_XC);
  const u16* WTP = (const u16*)(cx.ws + WS_WTP);
  float* X = (float*)(cx.ws + WS_X);
  TILE3_LOOP_BEGIN(8)
    f32x4 acc[5][4];
    acc_zero5(acc);
    gemm_mainloop3(cx, acc, MG + (long)mt * 160 * 1024, 1024, WTP + (long)(l * 4 + 3) * 1048576 + (long)nt * 128 * 1024, 1024, 1024);
    EPI5_BEGIN
      const int row = mt * 160 + lrow, col = nt * 128 + lcol;
      float4 x = *(const float4*)(X + (long)row * 1024 + col);
      x.x += v[0]; x.y += v[1]; x.z += v[2]; x.w += v[3];
      *(float4*)(X + (long)row * 1024 + col) = x;
    EPI5_END
  TILE_LOOP_END
}


#define HB_CNT(x)  (64 * (x))
#define HB_GEN(x)  (64 * (16 + (x)))
#define HB_CEN(x)  (64 * (32 + (x)))
#define HB_TOP     (64 * 48)
__device__ __forceinline__ unsigned hb_ld(unsigned* p) { return __hip_atomic_load(p, __ATOMIC_RELAXED, __HIP_MEMORY_SCOPE_AGENT); }
__device__ __forceinline__ unsigned hb_xcc() { return (unsigned)__builtin_amdgcn_s_getreg((3 << 11) | 20) & 0xFu; }
__device__ __forceinline__ void hier_barrier(unsigned* bar, unsigned k, volatile unsigned* st) {
  asm volatile("s_waitcnt vmcnt(0)" ::: "memory");
  __syncthreads();
  if (threadIdx.x == 0) {
    const unsigned x = hb_xcc();
    unsigned per = st[0], nx = st[1];
    if (per == 0u) {
      const unsigned G = gridDim.x;
      for (;;) {
        unsigned sum = 0u, cnt = 0u, mine = 0u;
#pragma unroll
        for (unsigned j = 0; j < 16; ++j) { const unsigned c = hb_ld(&bar[HB_CEN(j)]); sum += c; cnt += (c > 0u) ? 1u : 0u; mine = (j == x) ? c : mine; }
        if (sum == G) { per = mine; nx = cnt; break; }
        __builtin_amdgcn_s_sleep(1);
      }
      st[0] = per; st[1] = nx;
    }
    const unsigned old = __hip_atomic_fetch_add(&bar[HB_CNT(x)], 1u, __ATOMIC_RELAXED, __HIP_MEMORY_SCOPE_AGENT);
    if (old + 1u == per * k) {
      __builtin_amdgcn_fence(__ATOMIC_RELEASE, "agent");
      asm volatile("s_waitcnt vmcnt(0)" ::: "memory");
      const unsigned ot = __hip_atomic_fetch_add(&bar[HB_TOP], 1u, __ATOMIC_RELAXED, __HIP_MEMORY_SCOPE_AGENT);
      if (ot + 1u == nx * k) {
#pragma unroll
        for (unsigned j = 0; j < 16; ++j) __hip_atomic_store(&bar[HB_GEN(j)], k, __ATOMIC_RELAXED, __HIP_MEMORY_SCOPE_AGENT);
      }
    }
    while (hb_ld(&bar[HB_GEN(x)]) < k) __builtin_amdgcn_s_sleep(1);
    __builtin_amdgcn_fence(__ATOMIC_ACQUIRE, "agent");
    asm volatile("s_waitcnt vmcnt(0)" ::: "memory");
  }
  __syncthreads();
}

constexpr int PH_PER_LAYER = 11;
constexpr int N_PHASES = 1 + 4 * PH_PER_LAYER + 1;

__global__ void __launch_bounds__(256, 2) fwd_kernel(Params p) {
  cg::grid_group grid = cg::this_grid();
  volatile unsigned* hb_st = (volatile unsigned*)(smem + SMEM_CTL + 32);
  if (threadIdx.x == 0) { hb_st[0] = 0u; hb_st[1] = 0u; }
  __syncthreads();
  unsigned hb_k = 0u;
#pragma unroll 1
  for (int ph = p.ph0; ph < p.ph1; ++ph) {
    int zv = 0, zs = 0;
    asm volatile("" : "+v"(zv));
    asm volatile("" : "+s"(zs));
    Ctx cx;
    cx.tid = threadIdx.x + zv;
    cx.bid = blockIdx.x + zs;
    cx.nb = gridDim.x + zs;
    cx.ws = p.ws + zs;
    cx.out = p.out + zs;
    if (ph == 0) phase_convw(cx, p);
    else if (ph == N_PHASES - 1) phase_norm(cx, p, 4);
    else {
      const int l = (ph - 1) / PH_PER_LAYER, s = (ph - 1) % PH_PER_LAYER;
      switch (s) {
        case 0: phase_norm(cx, p, l); break;
        case 1: phase_inproj1(cx, p); if (PROBE_DUP & 1) { grid.sync(); phase_inproj1(cx, p); } break;
        case 2: phase_prep(cx, p, l); if (PROBE_DUP & 16) { grid.sync(); phase_prep(cx, p, l); } break;
        case 3: phase_mix1(cx, p, l); if (PROBE_DUP & 4) { grid.sync(); phase_mix1(cx, p, l); } break;
        case 4: if (PROBE_DUP & 64) { phase_mix2(cx, p, l, true); grid.sync(); } phase_mix2(cx, p, l); break;
        case 5: phase_mix3(cx, p, l); if (PROBE_DUP & 4) { grid.sync(); phase_mix3(cx, p, l); } break;
        case 6: if (PROBE_DUP & 128) { phase_rwprep(cx, p, l, true); grid.sync(); } phase_rwprep(cx, p, l); break;
        case 7: phase_rwscan(cx, p, l, l * 2); if (PROBE_DUP & 2) { grid.sync(); phase_rwscan(cx, p, l, l * 2 + 1); } break;
        case 8: phase_inproj2(cx, p, l); break;
        case 9: phase_merge(cx, p, l); break;
        default: phase_out(cx, p, l); break;
      }
    }
    if (ph + 1 < p.ph1) {
      if (ph == p.ph0) {
        grid.sync();
        if (threadIdx.x == 0) (void)__hip_atomic_fetch_add((unsigned*)(p.ws + WS_BAR) + HB_CEN(hb_xcc()), 1u, __ATOMIC_RELAXED, __HIP_MEMORY_SCOPE_AGENT);
      } else hier_barrier((unsigned*)(p.ws + WS_BAR), ++hb_k, hb_st);
    }
  }
}

extern "C" void kernel_launch(void* const* d_in, const int* in_sizes, int n_in, void* d_out, int out_size, void* d_ws, size_t ws_size,
                              hipStream_t stream) {
  static int grid_blocks = 0;
  if (!grid_blocks) {
    int dev = 0, cus = 0, per_cu = 0;
    hipGetDevice(&dev);
    hipDeviceGetAttribute(&cus, hipDeviceAttributeMultiprocessorCount, dev);
    (void)hipFuncSetAttribute((const void*)fwd_kernel, hipFuncAttributeMaxDynamicSharedMemorySize, SMEM_BYTES);
    hipOccupancyMaxActiveBlocksPerMultiprocessor(&per_cu, (const void*)fwd_kernel, 256, SMEM_BYTES);
    if (per_cu < 1) per_cu = 1;
    if (per_cu > 2) per_cu = 2;
    grid_blocks = cus * per_cu;
    if (ws_size < WS_END) fprintf(stderr, "workspace too small: %zu < %zu\n", ws_size, (size_t)WS_END);
  }
  if (n_in < 34 || ws_size < WS_END) return;
  Params p{};
  for (int i = 0; i < 34; ++i) p.in[i] = (const float*)d_in[i];
  p.out = (float*)d_out;
  p.ws = (unsigned char*)d_ws;
#if MULTI_LAUNCH
  for (int ph = 0; ph < N_PHASES; ++ph) {
    p.ph0 = ph; p.ph1 = ph + 1;
    hipLaunchKernelGGL(fwd_kernel, dim3(grid_blocks), dim3(256), SMEM_BYTES, stream, p);
  }
#else
  p.ph0 = 0; p.ph1 = N_PHASES;
  void* args[] = {&p};
  hipError_t e = hipLaunchCooperativeKernel((const void*)fwd_kernel, dim3(grid_blocks), dim3(256), args, SMEM_BYTES, stream);
  if (e != hipSuccess) fprintf(stderr, "cooperative launch failed: %s (grid %d)\n", hipGetErrorString(e), grid_blocks);
#endif
}
```
